# Optimizing an MI355X kernel written in HIP

```python
import math
import jax, jax.numpy as jnp
from jax import lax
import numpy as np

D_MODEL = 1024
BATCH = 8
SEQ = 8192
DEPTH = 4

CTX_LEN = 256
GRID_W = 64
EPS = 1e-6
ROPE_BASE = 10000.0
Q_BLOCK = 128
N_MOD = 9
D_FF = 2816
DIFF_HEADS = D_MODEL // 256
DIFF_HD = 64
DIFF_VD = 2 * DIFF_HD
MLA_HEADS = D_MODEL // 128
MLA_NOPE = 64
MLA_ROPE = 32
MLA_V = 64
MLA_Q_RANK = 3 * D_MODEL // 8
MLA_KV_RANK = D_MODEL // 4
IN_SIZES = (DIFF_HEADS * 2 * DIFF_HD, DIFF_HEADS * 2 * DIFF_HD, DIFF_HEADS * DIFF_VD, MLA_Q_RANK, MLA_KV_RANK, MLA_ROPE)
IN_W = sum(IN_SIZES)
IN_SPLITS = tuple(sum(IN_SIZES[:i + 1]) for i in range(len(IN_SIZES) - 1))
D_MIX = DIFF_HEADS * DIFF_VD + MLA_HEADS * MLA_V
POOL_WINDOWS = (2, 4, 8, 16)
POOL_GROUPS = len(POOL_WINDOWS)
POOL_GC = D_MODEL // POOL_GROUPS

kernel_name = 'hybrid_diffattn_mla_pool_macaron_dit'


def _rms(x, g):
    x32 = x.astype(jnp.float32)
    y = x32 * lax.rsqrt(jnp.mean(x32 * x32, axis=-1, keepdims=True) + EPS)
    return y.astype(x.dtype) * g


def _modulate(x, g, mod, i):
    return _rms(x, g) * (1.0 + mod[:, :, 3 * i + 1]) + mod[:, :, 3 * i]


def _swiglu(h, wg, wu, wd):
    return (jax.nn.silu(h @ wg) * (h @ wu)) @ wd


def _ffn_half(x, g, mod, i, wg, wu, wd):
    return x + 0.5 * mod[:, :, 3 * i + 2] * _swiglu(_modulate(x, g, mod, i), wg, wu, wd)


def _rope_tables(rows, cols, dim):
    q = dim // 4
    freqs = ROPE_BASE ** (-jnp.arange(q, dtype=jnp.float32) / q)
    ang = jnp.stack([rows.astype(jnp.float32)[:, None] * freqs, cols.astype(jnp.float32)[:, None] * freqs], axis=1)
    return jnp.cos(ang), jnp.sin(ang)


def _rope(x, cs):
    cos, sin = cs
    q = x.shape[-1] // 4
    xr = x.reshape(*x.shape[:-1], 2, 2, q)
    x1, x2 = xr[..., 0, :], xr[..., 1, :]
    shape = (cos.shape[0],) + (1,) * (x.ndim - 3) + (2, q)
    cos = cos.reshape(shape).astype(x.dtype)
    sin = sin.reshape(shape).astype(x.dtype)
    return jnp.stack([x1 * cos - x2 * sin, x2 * cos + x1 * sin], axis=-2).reshape(x.shape)


def _sweep_queries(fn, q):
    B, S = q.shape[:2]
    nb = S // Q_BLOCK
    qb = jnp.moveaxis(q.reshape(B, nb, Q_BLOCK, *q.shape[2:]), 1, 0)
    out = lax.map(fn, qb)
    return jnp.moveaxis(out, 0, 1).reshape(B, S, *out.shape[3:])


def _diff_attend(q, k, v, lam):
    s = jnp.einsum('bqhgd,bkhgd->bhgqk', q, k).astype(jnp.float32) * (DIFF_HD ** -0.5)
    p = jax.nn.softmax(s, axis=-1)
    a = (p[:, :, 0] - lam * p[:, :, 1]).astype(v.dtype)
    return jnp.einsum('bhqk,bkhe->bqhe', a, v)


def _mla_attend(q, k_nope, k_rope, v):
    qn, qr = q[..., :MLA_NOPE], q[..., MLA_NOPE:]
    s = jnp.einsum('bqhd,bkhd->bhqk', qn, k_nope) + jnp.einsum('bqhd,bkd->bhqk', qr, k_rope)
    p = jax.nn.softmax(s.astype(jnp.float32) * ((MLA_NOPE + MLA_ROPE) ** -0.5), axis=-1)
    return jnp.einsum('bhqk,bkhd->bqhd', p.astype(v.dtype), v)


def _attn_project(h, aw, rope):
    w_in, qk_g, q_a_g, w_q_b, kv_a_g, w_kv_b, nope_g, rope_g = aw
    B, L, _ = h.shape
    dq, dk, dv, cq, ckv, kr = jnp.split(h @ w_in, IN_SPLITS, axis=-1)
    dq = _rms(dq.reshape(B, L, DIFF_HEADS, 2, DIFF_HD), qk_g[0])
    dk = _rms(dk.reshape(B, L, DIFF_HEADS, 2, DIFF_HD), qk_g[1])
    dv = dv.reshape(B, L, DIFF_HEADS, DIFF_VD)
    mq = (_rms(cq, q_a_g) @ w_q_b).reshape(B, L, MLA_HEADS, MLA_NOPE + MLA_ROPE)
    kv = (_rms(ckv, kv_a_g) @ w_kv_b).reshape(B, L, MLA_HEADS, MLA_NOPE + MLA_V)
    qn = _rms(mq[..., :MLA_NOPE], nope_g[0])
    qr = _rms(mq[..., MLA_NOPE:], rope_g[0])
    kn = _rms(kv[..., :MLA_NOPE], nope_g[1])
    mv = kv[..., MLA_NOPE:]
    kr = _rms(kr, rope_g[1])
    if rope is not None:
        rope_d, rope_m = rope
        dq, dk = _rope(dq, rope_d), _rope(dk, rope_d)
        qr, kr = _rope(qr, rope_m), _rope(kr, rope_m)
    return dq, dk, dv, jnp.concatenate([qn, qr], axis=-1), kn, kr, mv


def _merge(diff_o, mla_o, subln_g, lam_init, w_out):
    B, L = diff_o.shape[:2]
    d = _rms(diff_o, subln_g) * (1.0 - lam_init)
    return jnp.concatenate([d.reshape(B, L, -1), mla_o.reshape(B, L, -1)], axis=-1) @ w_out


def _attn_mixer(hl, hc, aw, lam, lam_init, subln_g, w_out, rope_l, with_ctx_queries):
    dq_l, dk_l, dv_l, mq_l, mk_l, mr_l, mv_l = _attn_project(hl, aw, rope_l)
    dq_c, dk_c, dv_c, mq_c, mk_c, mr_c, mv_c = _attn_project(hc, aw, None)
    dk = jnp.concatenate([dk_c, dk_l], axis=1)
    dv = jnp.concatenate([dv_c, dv_l], axis=1)
    mk = jnp.concatenate([mk_c, mk_l], axis=1)
    mr = jnp.concatenate([mr_c, mr_l], axis=1)
    mv = jnp.concatenate([mv_c, mv_l], axis=1)
    diff_l = _sweep_queries(lambda qb: _diff_attend(qb, dk, dv, lam), dq_l)
    mla_l = _sweep_queries(lambda qb: _mla_attend(qb, mk, mr, mv), mq_l)
    yl = _merge(diff_l, mla_l, subln_g, lam_init, w_out)
    yc = None
    if with_ctx_queries:
        diff_c = _diff_attend(dq_c, dk_c, dv_c, lam)
        mla_c = _mla_attend(mq_c, mk_c, mr_c, mv_c)
        yc = _merge(diff_c, mla_c, subln_g, lam_init, w_out)
    return yl, yc


def _pool_mixer(h, w_pool, scale):
    B, L, D = h.shape
    h32 = h.astype(jnp.float32)
    prefix = jnp.concatenate([jnp.zeros((B, 1, D), jnp.float32), jnp.cumsum(h32, axis=1)], axis=1)
    t = jnp.arange(L)
    outs = []
    for gi, w in enumerate(POOL_WINDOWS):
        sl = slice(gi * POOL_GC, (gi + 1) * POOL_GC)
        lo = jnp.clip(t - w // 2, 0, L)
        hi = jnp.clip(t + (w - w // 2), 0, L)
        cnt = (hi - lo).astype(jnp.float32)[None, :, None]
        pg = prefix[..., sl]
        outs.append((pg[:, hi] - pg[:, lo]) / cnt - h32[..., sl])
    d = jnp.stack(outs, axis=2).astype(h.dtype)
    y = jnp.einsum('blgc,gcd->blgd', d, w_pool).reshape(B, L, D)
    return y * scale


def setup_inputs(seed: int = 0) -> dict:
    key = jax.random.key(seed)
    ks = jax.random.split(key, 24)
    f32 = jnp.float32
    n_even = (DEPTH + 1) // 2
    n_odd = DEPTH // 2

    def nrm(k, shape, scale):
        return jax.random.normal(k, shape, f32) * scale

    def gain(k, shape):
        return 1.0 + 0.05 * jax.random.normal(k, shape, f32)

    return {
        'x': nrm(ks[0], (BATCH, SEQ, D_MODEL), 1.0),
        'c': nrm(ks[1], (BATCH, D_MODEL), 1.0),
        'ctx': nrm(ks[2], (BATCH, CTX_LEN, D_MODEL), 1.0),
        'c_ctx': nrm(ks[3], (D_MODEL,), 1.0),
        'mod_w': nrm(ks[4], (DEPTH, D_MODEL, N_MOD * D_MODEL), 0.5 * D_MODEL ** -0.5),
        'mod_b': nrm(ks[5], (DEPTH, N_MOD * D_MODEL), 0.01),
        'norm_g': gain(ks[6], (DEPTH, 3, D_MODEL)),
        'ffn_w_gate': nrm(ks[7], (DEPTH, 2, D_MODEL, D_FF), D_MODEL ** -0.5),
        'ffn_w_up': nrm(ks[8], (DEPTH, 2, D_MODEL, D_FF), D_MODEL ** -0.5),
        'ffn_w_down': nrm(ks[9], (DEPTH, 2, D_FF, D_MODEL), D_FF ** -0.5),
        'attn_w_in': nrm(ks[10], (n_even, D_MODEL, IN_W), D_MODEL ** -0.5),
        'diff_qk_g': gain(ks[11], (n_even, 2, DIFF_HD)),
        'diff_lambda': nrm(ks[12], (n_even, 4, DIFF_HD), 0.1),
        'diff_subln_g': gain(ks[13], (n_even, DIFF_VD)),
        'mla_q_a_g': gain(ks[14], (n_even, MLA_Q_RANK)),
        'mla_w_q_b': nrm(ks[15], (n_even, MLA_Q_RANK, MLA_HEADS * (MLA_NOPE + MLA_ROPE)), MLA_Q_RANK ** -0.5),
        'mla_kv_a_g': gain(ks[16], (n_even, MLA_KV_RANK)),
        'mla_w_kv_b': nrm(ks[17], (n_even, MLA_KV_RANK, MLA_HEADS * (MLA_NOPE + MLA_V)), MLA_KV_RANK ** -0.5),
        'mla_nope_g': gain(ks[18], (n_even, 2, MLA_NOPE)),
        'mla_rope_g': gain(ks[19], (n_even, 2, MLA_ROPE)),
        'attn_w_out': nrm(ks[20], (n_even, D_MIX, D_MODEL), D_MIX ** -0.5),
        'pool_w': nrm(ks[21], (n_odd, POOL_GROUPS, POOL_GC, POOL_GC), POOL_GC ** -0.5),
        'pool_scale': gain(ks[22], (n_odd, D_MODEL)),
    }


def reference(x, c, ctx, c_ctx, mod_w, mod_b, norm_g, ffn_w_gate, ffn_w_up, ffn_w_down,
              attn_w_in, diff_qk_g, diff_lambda, diff_subln_g, mla_q_a_g, mla_w_q_b,
              mla_kv_a_g, mla_w_kv_b, mla_nope_g, mla_rope_g, attn_w_out, pool_w, pool_scale):
    B, S, D = x.shape
    n_rows = S // GRID_W
    rows = jnp.repeat(jnp.arange(n_rows), GRID_W)
    cols = jnp.tile(jnp.arange(GRID_W), n_rows)
    rope_l = (_rope_tables(rows, cols, DIFF_HD), _rope_tables(rows, cols, MLA_ROPE))
    s_c = jax.nn.silu(c)
    s_cc = jax.nn.silu(c_ctx)[None]
    xl, xc = x, ctx
    for layer in range(DEPTH):
        even = layer % 2 == 0
        ctx_out = layer < DEPTH - 1
        ctx_in = ctx_out or even
        i = layer // 2
        g = norm_g[layer]
        fw1 = (ffn_w_gate[layer, 0], ffn_w_up[layer, 0], ffn_w_down[layer, 0])
        fw2 = (ffn_w_gate[layer, 1], ffn_w_up[layer, 1], ffn_w_down[layer, 1])
        mod_l = (s_c @ mod_w[layer] + mod_b[layer]).reshape(B, 1, N_MOD, D)
        xl = _ffn_half(xl, g[0], mod_l, 0, *fw1)
        hl = _modulate(xl, g[1], mod_l, 1)
        mod_c, hc = None, None
        if ctx_in:
            mod_c = (s_cc @ mod_w[layer] + mod_b[layer]).reshape(1, 1, N_MOD, D)
            xc = _ffn_half(xc, g[0], mod_c, 0, *fw1)
            hc = _modulate(xc, g[1], mod_c, 1)
        if even:
            lam_init = 0.8 - 0.6 * math.exp(-0.3 * layer)
            dl = diff_lambda[i].astype(jnp.float32)
            lam = jnp.exp(jnp.sum(dl[0] * dl[1])) - jnp.exp(jnp.sum(dl[2] * dl[3])) + lam_init
            aw = (attn_w_in[i], diff_qk_g[i], mla_q_a_g[i], mla_w_q_b[i], mla_kv_a_g[i],
                  mla_w_kv_b[i], mla_nope_g[i], mla_rope_g[i])
            yl, yc = _attn_mixer(hl, hc, aw, lam, lam_init, diff_subln_g[i], attn_w_out[i], rope_l, ctx_out)
        else:
            yl = _pool_mixer(hl, pool_w[i], pool_scale[i])
            yc = _pool_mixer(hc, pool_w[i], pool_scale[i]) if ctx_out else None
        xl = xl + mod_l[:, :, 5] * yl
        xl = _ffn_half(xl, g[2], mod_l, 2, *fw2)
        if ctx_out:
            xc = xc + mod_c[:, :, 5] * yc
            xc = _ffn_half(xc, g[2], mod_c, 2, *fw2)
    return xl
```

```cpp
#include <hip/hip_runtime.h>
#include <hip/hip_cooperative_groups.h>
#include <cstdio>
namespace cg = cooperative_groups;

typedef unsigned short u16;
typedef __attribute__((ext_vector_type(8))) short bf16x8;
typedef __attribute__((ext_vector_type(16))) float f32x16;
typedef __attribute__((ext_vector_type(2))) float f32x2;
typedef __attribute__((ext_vector_type(4))) float f32x4;
typedef __attribute__((ext_vector_type(4))) unsigned u32x4;
typedef __attribute__((ext_vector_type(2))) __bf16 bf16x2_t;
#define DI __device__ __forceinline__
#define MFMA32(a, b, c) __builtin_amdgcn_mfma_f32_32x32x16_bf16((a), (b), (c), 0, 0, 0)

constexpr int NB = 8, SEQ = 8192, DM = 1024, CTXL = 256, DFF = 2816;
constexpr int ML = NB * SEQ, MC = NB * CTXL, MT = ML + MC, KP = SEQ + CTXL;
constexpr int INW = 2208, INWP = 2304;
constexpr int XNS = 1088, HS = 2880, KPS = 8512;
constexpr int NTHR = 512;
constexpr float QS_D = 0.125f * 1.4426950408889634f;
constexpr float QS_M = 0.10206207261596575f * 1.4426950408889634f;
constexpr int LDS_BYTES = 147456;

constexpr size_t al(size_t x) { return (x + 255) & ~size_t(255); }
constexpr size_t OFF_MOD = 0;
constexpr size_t OFF_ROPED = al(OFF_MOD + (size_t)4 * 9 * 9216 * 4);
constexpr size_t OFF_ROPEM = al(OFF_ROPED + 128 * 16 * 8);
constexpr size_t OFF_XC = al(OFF_ROPEM + 128 * 8 * 8);
constexpr size_t OFF_WIN = al(OFF_XC + (size_t)MC * DM * 4);
constexpr size_t OFF_WQB = al(OFF_WIN + (size_t)2 * INWP * XNS * 2);
constexpr size_t OFF_WKVB = al(OFF_WQB + (size_t)2 * 768 * 384 * 2);
constexpr size_t OFF_WOUT = al(OFF_WKVB + (size_t)2 * 1024 * 256 * 2);
constexpr size_t OFF_WPOOL = al(OFF_WOUT + (size_t)2 * 1024 * XNS * 2);
constexpr size_t OFF_WGU = al(OFF_WPOOL + (size_t)2 * 1024 * 256 * 2);
constexpr size_t OFF_WD = al(OFF_WGU + (size_t)2 * 5632 * XNS * 2);
constexpr size_t OFF_XN = al(OFF_WD + (size_t)2 * 1024 * HS * 2);
constexpr size_t OFF_BIG = al(OFF_XN + (size_t)MT * XNS * 2);
constexpr size_t SZ_HD = (size_t)NB * 8 * KP * 64 * 2;
constexpr size_t OFF_QD = al(OFF_BIG + (size_t)MT * HS * 2);
constexpr size_t OFF_KD = al(OFF_QD + SZ_HD);
constexpr size_t OFF_VDT = al(OFF_KD + SZ_HD);
constexpr size_t SZ_VT = (size_t)NB * 8 * 64 * KPS * 2;
constexpr size_t OFF_QM = al(OFF_VDT + SZ_VT);
constexpr size_t OFF_KN = al(OFF_QM + (size_t)NB * 8 * KP * 96 * 2);
constexpr size_t OFF_KR = al(OFF_KN + SZ_HD);
constexpr size_t OFF_VMT = al(OFF_KR + (size_t)NB * KP * 32 * 2);
constexpr size_t OFF_BAR = al(OFF_VMT + SZ_VT);
constexpr size_t WS_NEED = al(OFF_BAR + 256);

struct Ctx { int tid, bid, nb; };

struct Params {
  const float *x, *c, *ctx, *c_ctx, *mod_w, *mod_b, *norm_g, *wg, *wu, *wd, *w_in, *qk_g, *dlam, *subln_g,
      *q_a_g, *w_q_b, *kv_a_g, *w_kv_b, *nope_g, *rope_g, *w_out, *pool_w, *pool_scale;
  float* out;
  char* ws;
};

DI float bf2f(u16 v) { return __uint_as_float(((unsigned)v) << 16); }
DI unsigned pk2(float a, float b) {
  f32x2 v = {a, b};
  bf16x2_t r = __builtin_convertvector(v, bf16x2_t);
  return __builtin_bit_cast(unsigned, r);
}
DI void unpack8(uint4 v, float* f) {
  f[0] = __uint_as_float(v.x << 16); f[1] = __uint_as_float(v.x & 0xffff0000u);
  f[2] = __uint_as_float(v.y << 16); f[3] = __uint_as_float(v.y & 0xffff0000u);
  f[4] = __uint_as_float(v.z << 16); f[5] = __uint_as_float(v.z & 0xffff0000u);
  f[6] = __uint_as_float(v.w << 16); f[7] = __uint_as_float(v.w & 0xffff0000u);
}
DI uint4 pack8(const float* f) {
  uint4 o; o.x = pk2(f[0], f[1]); o.y = pk2(f[2], f[3]); o.z = pk2(f[4], f[5]); o.w = pk2(f[6], f[7]);
  return o;
}
DI int vperm16(int pos) { return (pos & ~12) | ((pos & 4) << 1) | ((pos & 8) >> 1); }

DI void tr_convert(const Ctx cx, const float* __restrict__ src, int K, int N, u16* __restrict__ dst, int ldd, int mode, float* tile) {
  const int tid = cx.tid;
  const int nkt = K / 64, nnt = (N + 63) / 64;
  const int total = nkt * nnt;
  constexpr int NT = 4;
  for (int u = cx.bid; u < total; u += NT * cx.nb) {
    float4 v[NT][2];
#pragma unroll
    for (int t = 0; t < NT; t++) {
      const int uu = u + t * cx.nb;
      const int kt = uu / nnt, nt = uu % nnt;
      const int k0 = kt * 64, n0 = nt * 64;
#pragma unroll
      for (int i = 0; i < 2; i++) {
        const int k = (tid >> 4) + 32 * i, n4 = (tid & 15) * 4;
        v[t][i] = make_float4(0.f, 0.f, 0.f, 0.f);
        if (uu < total && n0 + n4 < N) v[t][i] = *(const float4*)(src + (size_t)(k0 + k) * N + n0 + n4);
      }
    }
#pragma unroll
    for (int t = 0; t < NT; t++)
#pragma unroll
      for (int i = 0; i < 2; i++) {
        const int k = (tid >> 4) + 32 * i, n4 = (tid & 15) * 4;
        float* tl = tile + t * (64 * 65);
        tl[k * 65 + n4 + 0] = v[t][i].x; tl[k * 65 + n4 + 1] = v[t][i].y; tl[k * 65 + n4 + 2] = v[t][i].z; tl[k * 65 + n4 + 3] = v[t][i].w;
      }
    __syncthreads();
#pragma unroll
    for (int t = 0; t < NT; t++) {
      const int uu = u + t * cx.nb;
      const int kt = uu / nnt, nt = uu % nnt;
      const int k0 = kt * 64, n0 = nt * 64;
      const int n = tid >> 3, kc = (tid & 7) * 8;
      if (uu < total && n0 + n < N) {
        const float* tl = tile + t * (64 * 65);
        float f[8];
#pragma unroll
        for (int j = 0; j < 8; j++) f[j] = tl[(kc + j) * 65 + n];
        const int j = n0 + n;
        const int row = (mode == 0) ? j : ((j >> 5) * 64 + (j & 31) + (mode == 2 ? 32 : 0));
        *(uint4*)(dst + (size_t)row * ldd + k0 + kc) = pack8(f);
      }
    }
    __syncthreads();
  }
}

DI void phase_prep(const Ctx cx, const Params& p, char* smem) {
  const int tid = cx.tid, lane = tid & 63, w = tid >> 6;
  float* lds = (float*)smem;
  float* MOD = (float*)(p.ws + OFF_MOD);
  if (cx.bid == cx.nb - 1) {
    float2* RD = (float2*)(p.ws + OFF_ROPED);
    float2* RM = (float2*)(p.ws + OFF_ROPEM);
    for (int i = tid; i < 128 * 16 + 128 * 8; i += NTHR) {
      int pos, j, q; float2* dst;
      if (i < 128 * 16) { pos = i >> 4; j = i & 15; q = 16; dst = RD + i; }
      else { int ii = i - 128 * 16; pos = ii >> 3; j = ii & 7; q = 8; dst = RM + ii; }
      const float freq = exp2f(-(float)j / (float)q * 13.287712379549449f);
      const float ang = (float)pos * freq;
      const float n = rintf(ang * 0.15915494309189535f);
      float r = fmaf(-n, 6.2831854820251465f, ang);
      r = fmaf(-n, -1.7484555e-7f, r);
      *dst = make_float2(__cosf(r), __sinf(r));
    }
  }
  {
    float* sil = lds;
    float* red = lds + 9 * 1024;
    for (int i = tid; i < 9 * 1024; i += NTHR) {
      const int s = i >> 10, k = i & 1023;
      const float v = (s < 8) ? p.c[s * 1024 + k] : p.c_ctx[k];
      sil[i] = v / (1.f + __expf(-v));
    }
    __syncthreads();
    for (int u = cx.bid; u < 4 * 144; u += cx.nb) {
      const int layer = u / 144, cgp = u % 144;
      const int col = cgp * 64 + lane;
      const float* wp = p.mod_w + (size_t)layer * 1024 * 9216 + col;
      float acc[9];
#pragma unroll
      for (int s = 0; s < 9; s++) acc[s] = 0.f;
      const int kb = w * 128;
#pragma unroll 8
      for (int k = kb; k < kb + 128; k++) {
        const float wv = wp[(size_t)k * 9216];
#pragma unroll
        for (int s = 0; s < 9; s++) acc[s] = fmaf(sil[s * 1024 + k], wv, acc[s]);
      }
#pragma unroll
      for (int s = 0; s < 9; s++) red[(w * 9 + s) * 64 + lane] = acc[s];
      __syncthreads();
      for (int i = tid; i < 576; i += NTHR) {
        const int s = i >> 6, cc = i & 63;
        float t = 0.f;
#pragma unroll
        for (int ww = 0; ww < 8; ww++) t += red[(ww * 9 + s) * 64 + cc];
        const int c2 = cgp * 64 + cc;
        MOD[((size_t)layer * 9 + s) * 9216 + c2] = t + p.mod_b[layer * 9216 + c2];
      }
      __syncthreads();
    }
  }
#pragma unroll 1
  for (int t = 0; t < 16; t++) {
    const int i = t >> 3, j = t & 7;
    const float* s; int K, N, ldd; u16* d;
    if (j == 0) { s = p.w_in + (size_t)i * 1024 * INW; K = 1024; N = INW; d = (u16*)(p.ws + OFF_WIN) + (size_t)i * INWP * XNS; ldd = XNS; }
    else if (j == 1) { s = p.w_q_b + (size_t)i * 384 * 768; K = 384; N = 768; d = (u16*)(p.ws + OFF_WQB) + (size_t)i * 768 * 384; ldd = 384; }
    else if (j == 2) { s = p.w_kv_b + (size_t)i * 256 * 1024; K = 256; N = 1024; d = (u16*)(p.ws + OFF_WKVB) + (size_t)i * 1024 * 256; ldd = 256; }
    else if (j == 3) { s = p.w_out + (size_t)i * 1024 * 1024; K = 1024; N = 1024; d = (u16*)(p.ws + OFF_WOUT) + (size_t)i * 1024 * XNS; ldd = XNS; }
    else { const int g = j - 4; s = p.pool_w + (size_t)(i * 4 + g) * 65536; K = 256; N = 256; d = (u16*)(p.ws + OFF_WPOOL) + (size_t)i * 1024 * 256 + (size_t)g * 65536; ldd = 256; }
    tr_convert(cx, s, K, N, d, ldd, 0, lds);
  }
}

DI void convert_ffn_weights(const Ctx cx, const Params& p, int layer, char* smem) {
  float* lds = (float*)smem;
#pragma unroll 1
  for (int t = 0; t < 6; t++) {
    const int f = t / 3, kind = t % 3;
    const size_t mi = (size_t)(layer * 2 + f);
    const float* s; int K, N, ldd, mode; u16* d;
    if (kind == 0) { s = p.wg + mi * 1024 * DFF; K = 1024; N = DFF; d = (u16*)(p.ws + OFF_WGU) + (size_t)f * 5632 * XNS; ldd = XNS; mode = 1; }
    else if (kind == 1) { s = p.wu + mi * 1024 * DFF; K = 1024; N = DFF; d = (u16*)(p.ws + OFF_WGU) + (size_t)f * 5632 * XNS; ldd = XNS; mode = 2; }
    else { s = p.wd + mi * DFF * 1024; K = DFF; N = 1024; d = (u16*)(p.ws + OFF_WD) + (size_t)f * 1024 * HS; ldd = HS; mode = 0; }
    tr_convert(cx, s, K, N, d, ldd, mode, lds);
  }
}

DI float wave_sum(float v) {
#pragma unroll
  for (int m = 32; m >= 1; m >>= 1) v += __shfl_xor(v, m);
  return v;
}
DI void phase_norm(const Ctx cx, const Params& p, const float* xl, const float* xc, int nrows, int layer, int sub) {
  const int lane = cx.tid & 63, w = cx.tid >> 6;
  const float* g = p.norm_g + (size_t)(layer * 3 + sub) * 1024;
  const float* MOD = (const float*)(p.ws + OFF_MOD);
  u16* XN = (u16*)(p.ws + OFF_XN);
  constexpr int NR = 4;
  for (int r0 = (cx.bid * 8 + w) * NR; r0 < nrows; r0 += cx.nb * 8 * NR) {
    const float* xr[NR]; int s[NR];
#pragma unroll
    for (int j = 0; j < NR; j++) {
      const int r = r0 + j;
      if (r < ML) { xr[j] = xl + (size_t)r * 1024; s[j] = r >> 13; } else { xr[j] = xc + (size_t)(r - ML) * 1024; s[j] = 8; }
    }
    float4 v[NR][4]; float ss[NR];
#pragma unroll
    for (int j = 0; j < NR; j++)
#pragma unroll
      for (int i = 0; i < 4; i++) v[j][i] = *(const float4*)(xr[j] + (i * 64 + lane) * 4);
#pragma unroll
    for (int j = 0; j < NR; j++) {
      ss[j] = 0.f;
#pragma unroll
      for (int i = 0; i < 4; i++) ss[j] += v[j][i].x * v[j][i].x + v[j][i].y * v[j][i].y + v[j][i].z * v[j][i].z + v[j][i].w * v[j][i].w;
      ss[j] = wave_sum(ss[j]);
    }
#pragma unroll
    for (int j = 0; j < NR; j++) {
      const float rstd = rsqrtf(ss[j] * (1.f / 1024.f) + 1e-6f);
      const float* md = MOD + ((size_t)layer * 9 + s[j]) * 9216 + (size_t)(3 * sub) * 1024;
#pragma unroll
      for (int i = 0; i < 4; i++) {
        const int col = (i * 64 + lane) * 4;
        const float4 g4 = *(const float4*)(g + col);
        const float4 sh = *(const float4*)(md + col);
        const float4 sc = *(const float4*)(md + 1024 + col);
        const float y0 = v[j][i].x * rstd * g4.x * (1.f + sc.x) + sh.x;
        const float y1 = v[j][i].y * rstd * g4.y * (1.f + sc.y) + sh.y;
        const float y2 = v[j][i].z * rstd * g4.z * (1.f + sc.z) + sh.z;
        const float y3 = v[j][i].w * rstd * g4.w * (1.f + sc.w) + sh.w;
        uint2 o; o.x = pk2(y0, y1); o.y = pk2(y2, y3);
        *(uint2*)(XN + (size_t)(r0 + j) * XNS + col) = o;
      }
    }
  }
}

enum { EPI_GU = 0, EPI_RES = 1, EPI_RAW = 2 };
struct GemmArgs {
  const u16* A; int lda; int a_koff;
  const u16* W; int ldw;
  int K, nMt, nNt;
  u16* outb; int ldo; int ncols;
  const float* xsl; const float* xsc; float* xdl; float* xdc;
  const float* mod; int gidx; float coef; const float* colscale;
};

DI void gemm_phase(const Ctx cx, const GemmArgs& g, const int EPI, char* smem) {
  const int tid = cx.tid, lane = tid & 63, w = tid >> 6, wm = w >> 2, wn = w & 3;
  const int l16 = lane & 15, kg = lane >> 4;
  const int ntiles = g.nMt * g.nNt;
  const int nk = g.K >> 6;
  const int nb = cx.nb;
  const int vb = (nb % 8 == 0) ? ((cx.bid & 7) * (nb >> 3) + (cx.bid >> 3)) : cx.bid;
  const int srow = tid >> 3, sch = tid & 7;
  const int wsl = (sch ^ ((srow >> 1) & 7)) * 16;
  const int swr = l16 >> 1;
  const int ro0 = ((0 + kg) ^ swr) * 16, ro1 = ((4 + kg) ^ swr) * 16;
  u32x4 ra[4], rb[4];
  bool primed = false;
#pragma unroll 1
  for (int T = vb; T < ntiles; T += nb) {
    const int grp = T / (4 * g.nNt), within = T % (4 * g.nNt);
    const int mt = grp * 4 + (within & 3), nt = within >> 2;
    const u16* Ag = g.A + (size_t)(mt * 256 + srow) * g.lda + (size_t)nt * g.a_koff + sch * 8;
    const u16* Wg = g.W + (size_t)(nt * 256 + srow) * g.ldw + sch * 8;
    long dA = 0, dW = 0;
    {
      const int Tn = T + nb;
      if (Tn < ntiles) {
        const int grpn = Tn / (4 * g.nNt), withinn = Tn % (4 * g.nNt);
        const int mtn = grpn * 4 + (withinn & 3), ntn = withinn >> 2;
        dA = (long)(mtn - mt) * 256 * g.lda + (long)(ntn - nt) * g.a_koff;
        dW = (long)(ntn - nt) * 256 * g.ldw;
      }
    }
    f32x4 acc[8][4];
#pragma unroll
    for (int mi = 0; mi < 8; mi++)
#pragma unroll
      for (int ni = 0; ni < 4; ni++)
#pragma unroll
        for (int r = 0; r < 4; r++) acc[mi][ni][r] = 0.f;
    if (!primed) {
      primed = true;
#pragma unroll
      for (int i = 0; i < 4; i++) {
        ra[i] = *(const u32x4*)(Ag + (size_t)(64 * i) * g.lda);
        rb[i] = *(const u32x4*)(Wg + (size_t)(64 * i) * g.ldw);
      }
#pragma unroll
      for (int i = 0; i < 4; i++) {
        *(u32x4*)(smem + (srow + 64 * i) * 128 + wsl) = ra[i];
        *(u32x4*)(smem + 32768 + (srow + 64 * i) * 128 + wsl) = rb[i];
      }
#pragma unroll
      for (int i = 0; i < 4; i++) {
        ra[i] = *(const u32x4*)(Ag + (size_t)(64 * i) * g.lda + 64);
        rb[i] = *(const u32x4*)(Wg + (size_t)(64 * i) * g.ldw + 64);
      }
      __syncthreads();
    }
    __builtin_amdgcn_s_waitcnt(0x0F70);
#pragma unroll 1
    for (int kt = 0; kt < nk; kt++) {
      const int cur = kt & 1;
      const bool nx = (kt + 2 >= nk);
      const long k2a = nx ? dA + (long)(kt + 2 - nk) * 64 : (long)(kt + 2) * 64;
      const long k2w = nx ? dW + (long)(kt + 2 - nk) * 64 : (long)(kt + 2) * 64;
      const char* As = smem + cur * 65536 + (wm * 128 + l16) * 128;
      const char* Bs = smem + cur * 65536 + 32768 + (wn * 64 + l16) * 128;
      char* dA_ = smem + (cur ^ 1) * 65536 + srow * 128 + wsl;
      bf16x8 bf[2][4], af[2][4];
#pragma unroll
      for (int ni = 0; ni < 4; ni++) bf[0][ni] = *(const bf16x8*)(Bs + ni * 2048 + ro0);
#pragma unroll
      for (int mi = 0; mi < 4; mi++) af[0][mi] = *(const bf16x8*)(As + mi * 2048 + ro0);
#pragma unroll
      for (int q = 0; q < 4; q++) {
        const int s = q >> 1, hm = q & 1;
        if (q == 0) {
#pragma unroll
          for (int mi = 0; mi < 4; mi++) af[1][mi] = *(const bf16x8*)(As + (4 + mi) * 2048 + ro0);
#pragma unroll
          for (int ni = 0; ni < 4; ni++) bf[1][ni] = *(const bf16x8*)(Bs + ni * 2048 + ro1);
        } else if (q == 1) {
#pragma unroll
          for (int mi = 0; mi < 4; mi++) af[0][mi] = *(const bf16x8*)(As + mi * 2048 + ro1);
        } else if (q == 2) {
#pragma unroll
          for (int mi = 0; mi < 4; mi++) af[1][mi] = *(const bf16x8*)(As + (4 + mi) * 2048 + ro1);
        }
        if (q >= 1) {
#pragma unroll
          for (int i = (q == 3 ? 2 : q - 1); i < (q == 3 ? 4 : q); i++) {
            *(u32x4*)(dA_ + 64 * i * 128) = ra[i];
            *(u32x4*)(dA_ + 32768 + 64 * i * 128) = rb[i];
          }
#pragma unroll
          for (int i = (q == 3 ? 2 : q - 1); i < (q == 3 ? 4 : q); i++) {
            ra[i] = *(const u32x4*)(Ag + (long)(64 * i) * g.lda + k2a);
            rb[i] = *(const u32x4*)(Wg + (long)(64 * i) * g.ldw + k2w);
          }
        }
#pragma unroll
        for (int mi = 0; mi < 4; mi++)
#pragma unroll
          for (int ni = 0; ni < 4; ni++)
            acc[hm * 4 + mi][ni] = __builtin_amdgcn_mfma_f32_16x16x32_bf16(af[hm][mi], bf[s][ni], acc[hm * 4 + mi][ni], 0, 0, 0);
      }
      __builtin_amdgcn_sched_group_barrier(0x100, 8, 0);
#pragma unroll
      for (int j = 0; j < 8; j++) { __builtin_amdgcn_sched_group_barrier(0x008, 2, 0); __builtin_amdgcn_sched_group_barrier(0x100, 1, 0); }
#pragma unroll
      for (int qq = 0; qq < 2; qq++) {
#pragma unroll
        for (int j = 0; j < 4; j++) { __builtin_amdgcn_sched_group_barrier(0x008, 2, 0); __builtin_amdgcn_sched_group_barrier(0x100, 1, 0); }
#pragma unroll
        for (int j = 0; j < 2; j++) { __builtin_amdgcn_sched_group_barrier(0x008, 2, 0); __builtin_amdgcn_sched_group_barrier(0x200, 1, 0); }
#pragma unroll
        for (int j = 0; j < 2; j++) { __builtin_amdgcn_sched_group_barrier(0x008, 2, 0); __builtin_amdgcn_sched_group_barrier(0x020, 1, 0); }
      }
#pragma unroll
      for (int j = 0; j < 4; j++) { __builtin_amdgcn_sched_group_barrier(0x008, 2, 0); __builtin_amdgcn_sched_group_barrier(0x200, 1, 0); }
#pragma unroll
      for (int j = 0; j < 4; j++) { __builtin_amdgcn_sched_group_barrier(0x008, 2, 0); __builtin_amdgcn_sched_group_barrier(0x020, 1, 0); }
      __syncthreads();
    }
    const int m0 = mt * 256 + wm * 128, n0 = nt * 256 + wn * 64;
    if (EPI == EPI_GU) {
      u16* ob = g.outb + (size_t)(m0 + 4 * kg) * g.ldo + (n0 >> 1) + l16;
      const size_t st16 = (size_t)16 * g.ldo;
#pragma unroll
      for (int mi = 0; mi < 8; mi++) {
#pragma unroll
        for (int ni = 0; ni < 2; ni++)
#pragma unroll
          for (int r = 0; r < 4; r++) {
            const float gt = acc[mi][ni][r], up = acc[mi][ni + 2][r];
            const float y = gt / (1.f + __expf(-gt)) * up;
            ob[(size_t)r * g.ldo + ni * 16] = (u16)(pk2(y, 0.f) & 0xffffu);
          }
        ob += st16;
        asm volatile("" : "+v"(ob) : : "memory");
      }
    } else if (EPI == EPI_RAW) {
      u16* ob = g.outb + (size_t)(m0 + 4 * kg) * g.ldo + n0 + l16;
      const size_t st16 = (size_t)16 * g.ldo;
#pragma unroll
      for (int mi = 0; mi < 8; mi++) {
#pragma unroll
        for (int ni = 0; ni < 4; ni++) {
          if (n0 + ni * 16 + l16 < g.ncols) {
#pragma unroll
            for (int r = 0; r < 4; r++) ob[(size_t)r * g.ldo + ni * 16] = (u16)(pk2(acc[mi][ni][r], 0.f) & 0xffffu);
          }
        }
        ob += st16;
        asm volatile("" : "+v"(ob) : : "memory");
      }
    } else {
      const float* xs; float* xd; int s; int mb;
      if (mt < 256) { xs = g.xsl; xd = g.xdl; s = mt >> 5; mb = m0; }
      else { xs = g.xsc; xd = g.xdc; s = 8; mb = m0 - ML; }
      const float* modrow = g.mod + (size_t)s * 9216 + (size_t)g.gidx * 1024;
      float gm[4];
#pragma unroll
      for (int ni = 0; ni < 4; ni++) {
        const int n = n0 + ni * 16 + l16;
        gm[ni] = g.coef * modrow[n] * (g.colscale ? g.colscale[n] : 1.f);
      }
      const size_t base = (size_t)(mb + 4 * kg) * 1024 + n0 + l16;
      const float* xsp = xs + base;
      float* xdp = xd + base;
#pragma unroll
      for (int mi = 0; mi < 8; mi++) {
        float t[16];
#pragma unroll
        for (int ni = 0; ni < 4; ni++)
#pragma unroll
          for (int r = 0; r < 4; r++) t[ni * 4 + r] = xsp[r * 1024 + ni * 16];
#pragma unroll
        for (int ni = 0; ni < 4; ni++)
#pragma unroll
          for (int r = 0; r < 4; r++) xdp[r * 1024 + ni * 16] = t[ni * 4 + r] + gm[ni] * acc[mi][ni][r];
        xsp += 16 * 1024; xdp += 16 * 1024;
        asm volatile("" : "+v"(xsp), "+v"(xdp) : : "memory");
      }
    }
  }
}

DI void row_info(int r, int& b, int& pos, bool& lat, int& prow, int& pcol) {
  if (r < ML) { b = r >> 13; const int t = r & 8191; pos = 256 + t; lat = true; prow = t >> 6; pcol = t & 63; }
  else { const int rr = r - ML; b = rr >> 8; pos = rr & 255; lat = false; prow = 0; pcol = 0; }
}

DI void phase_post1(const Ctx cx, const Params& p, int ai) {
  const int lane = cx.tid & 63, w = cx.tid >> 6;
  const u16* RAW = (const u16*)(p.ws + OFF_BIG);
  u16* QD = (u16*)(p.ws + OFF_QD); u16* KD = (u16*)(p.ws + OFF_KD); u16* VDT = (u16*)(p.ws + OFF_VDT);
  u16* CQN = (u16*)(p.ws + OFF_XN); u16* CKVN = CQN + (size_t)MT * 384;
  u16* KR = (u16*)(p.ws + OFF_KR);
  const float2* RD = (const float2*)(p.ws + OFF_ROPED);
  const float2* RM = (const float2*)(p.ws + OFF_ROPEM);
  const float* qkg = p.qk_g + ai * 128;
  const float* qag = p.q_a_g + ai * 384;
  const float* kvag = p.kv_a_g + ai * 256;
  const float* ropeg = p.rope_g + ai * 64 + 32;
  for (int r = cx.bid * 8 + w; r < MT; r += cx.nb * 8) {
    int b, pos, prow, pcol; bool lat;
    row_info(r, b, pos, lat, prow, pcol);
    const u16* rr = RAW + (size_t)r * INW;
    const int li = lane & 7, sh = lane >> 3;
#pragma unroll
    for (int which = 0; which < 2; which++) {
      float v[8];
      unpack8(*(const uint4*)(rr + which * 512 + lane * 8), v);
      float ss = 0.f;
#pragma unroll
      for (int i = 0; i < 8; i++) ss += v[i] * v[i];
      ss += __shfl_xor(ss, 1); ss += __shfl_xor(ss, 2); ss += __shfl_xor(ss, 4);
      const float rstd = rsqrtf(ss * (1.f / 64.f) + 1e-6f);
      float y[8];
#pragma unroll
      for (int i = 0; i < 8; i++) y[i] = v[i] * rstd * qkg[which * 64 + li * 8 + i];
      float o[8];
      const int a = li >> 2, ph = (li >> 1) & 1;
      const int pa = a ? pcol : prow;
#pragma unroll
      for (int i = 0; i < 8; i++) {
        const float pr = __shfl_xor(y[i], 2);
        const float2 cs = RD[pa * 16 + (li & 1) * 8 + i];
        const float rot = ph ? (y[i] * cs.x + pr * cs.y) : (y[i] * cs.x - pr * cs.y);
        o[i] = (lat ? rot : y[i]) * (which ? 1.f : QS_D);
      }
      u16* dst = (which ? KD : QD) + ((size_t)(b * 8 + sh) * KP + pos) * 64 + li * 8;
      *(uint4*)dst = pack8(o);
    }
    {
      float v[8];
      uint4 raw = make_uint4(0, 0, 0, 0);
      if (lane < 48) raw = *(const uint4*)(rr + 1536 + lane * 8);
      unpack8(raw, v);
      float ss = 0.f;
#pragma unroll
      for (int i = 0; i < 8; i++) ss += v[i] * v[i];
      ss = wave_sum(ss);
      const float rstd = rsqrtf(ss * (1.f / 384.f) + 1e-6f);
      if (lane < 48) {
        float o[8];
#pragma unroll
        for (int i = 0; i < 8; i++) o[i] = v[i] * rstd * qag[lane * 8 + i];
        *(uint4*)(CQN + (size_t)r * 384 + lane * 8) = pack8(o);
      }
    }
    {
      float v[8];
      uint4 raw = make_uint4(0, 0, 0, 0);
      if (lane < 32) raw = *(const uint4*)(rr + 1920 + lane * 8);
      unpack8(raw, v);
      float ss = 0.f;
#pragma unroll
      for (int i = 0; i < 8; i++) ss += v[i] * v[i];
      ss = wave_sum(ss);
      const float rstd = rsqrtf(ss * (1.f / 256.f) + 1e-6f);
      if (lane < 32) {
        float o[8];
#pragma unroll
        for (int i = 0; i < 8; i++) o[i] = v[i] * rstd * kvag[lane * 8 + i];
        *(uint4*)(CKVN + (size_t)r * 256 + lane * 8) = pack8(o);
      }
    }
    {
      float v[8];
      uint4 raw = make_uint4(0, 0, 0, 0);
      if (lane < 4) raw = *(const uint4*)(rr + 2176 + lane * 8);
      unpack8(raw, v);
      float ss = 0.f;
#pragma unroll
      for (int i = 0; i < 8; i++) ss += v[i] * v[i];
      ss += __shfl_xor(ss, 1); ss += __shfl_xor(ss, 2);
      const float rstd = rsqrtf(ss * (1.f / 32.f) + 1e-6f);
      float y[8], o[8];
      const int l4 = lane & 3;
#pragma unroll
      for (int i = 0; i < 8; i++) y[i] = v[i] * rstd * ropeg[l4 * 8 + i];
      const int a = l4 >> 1, ph = l4 & 1;
      const int pa = a ? pcol : prow;
#pragma unroll
      for (int i = 0; i < 8; i++) {
        const float pr = __shfl_xor(y[i], 1);
        const float2 cs = RM[pa * 8 + i];
        const float rot = ph ? (y[i] * cs.x + pr * cs.y) : (y[i] * cs.x - pr * cs.y);
        o[i] = lat ? rot : y[i];
      }
      if (lane < 4) *(uint4*)(KR + ((size_t)b * KP + pos) * 32 + lane * 8) = pack8(o);
    }
  }
  for (int task0 = (cx.bid * 8 + w) * 2; task0 < (MT / 64) * 64; task0 += cx.nb * 16) {
    uint4 raw[2]; u16* dst[2];
#pragma unroll
    for (int j = 0; j < 2; j++) {
      const int task = task0 + j;
      const int tt = task >> 6, c = task & 63;
      const int r = tt * 64 + lane;
      int b, pos, prow, pcol; bool lat;
      row_info(r, b, pos, lat, prow, pcol);
      raw[j] = *(const uint4*)(RAW + (size_t)r * INW + 1024 + c * 8);
      const int head = c >> 4, dv0 = (c & 15) * 8;
      dst[j] = VDT + ((size_t)(b * 4 + head) * 128 + dv0) * KPS + vperm16(pos);
    }
#pragma unroll
    for (int j = 0; j < 2; j++) {
      dst[j][0 * (size_t)KPS] = (u16)(raw[j].x & 0xffffu); dst[j][1 * (size_t)KPS] = (u16)(raw[j].x >> 16);
      dst[j][2 * (size_t)KPS] = (u16)(raw[j].y & 0xffffu); dst[j][3 * (size_t)KPS] = (u16)(raw[j].y >> 16);
      dst[j][4 * (size_t)KPS] = (u16)(raw[j].z & 0xffffu); dst[j][5 * (size_t)KPS] = (u16)(raw[j].z >> 16);
      dst[j][6 * (size_t)KPS] = (u16)(raw[j].w & 0xffffu); dst[j][7 * (size_t)KPS] = (u16)(raw[j].w >> 16);
    }
  }
}

DI void phase_post2(const Ctx cx, const Params& p, int ai) {
  const int lane = cx.tid & 63, w = cx.tid >> 6;
  const u16* MQ = (const u16*)(p.ws + OFF_BIG);
  const u16* KV = MQ + (size_t)MT * 768;
  u16* QM = (u16*)(p.ws + OFF_QM); u16* KN = (u16*)(p.ws + OFF_KN); u16* VMT = (u16*)(p.ws + OFF_VMT);
  const float2* RM = (const float2*)(p.ws + OFF_ROPEM);
  const float* nopeg = p.nope_g + ai * 128;
  const float* ropeg = p.rope_g + ai * 64;
  for (int r = cx.bid * 8 + w; r < MT; r += cx.nb * 8) {
    int b, pos, prow, pcol; bool lat;
    row_info(r, b, pos, lat, prow, pcol);
    const int head = lane >> 3, sub = lane & 7;
    {
      float v[8];
      unpack8(*(const uint4*)(MQ + (size_t)r * 768 + head * 96 + sub * 8), v);
      float ss = 0.f;
#pragma unroll
      for (int i = 0; i < 8; i++) ss += v[i] * v[i];
      ss += __shfl_xor(ss, 1); ss += __shfl_xor(ss, 2); ss += __shfl_xor(ss, 4);
      const float rstd = rsqrtf(ss * (1.f / 64.f) + 1e-6f);
      float o[8];
#pragma unroll
      for (int i = 0; i < 8; i++) o[i] = v[i] * rstd * nopeg[sub * 8 + i] * QS_M;
      *(uint4*)(QM + ((size_t)(b * 8 + head) * KP + pos) * 96 + sub * 8) = pack8(o);
    }
    {
      float v[8];
      uint4 raw = make_uint4(0, 0, 0, 0);
      if (sub < 4) raw = *(const uint4*)(MQ + (size_t)r * 768 + head * 96 + 64 + sub * 8);
      unpack8(raw, v);
      float ss = 0.f;
#pragma unroll
      for (int i = 0; i < 8; i++) ss += v[i] * v[i];
      ss += __shfl_xor(ss, 1); ss += __shfl_xor(ss, 2);
      const float rstd = rsqrtf(ss * (1.f / 32.f) + 1e-6f);
      float y[8], o[8];
      const int s4 = sub & 3;
#pragma unroll
      for (int i = 0; i < 8; i++) y[i] = v[i] * rstd * ropeg[s4 * 8 + i];
      const int a = s4 >> 1, ph = s4 & 1;
      const int pa = a ? pcol : prow;
#pragma unroll
      for (int i = 0; i < 8; i++) {
        const float pr = __shfl_xor(y[i], 1);
        const float2 cs = RM[pa * 8 + i];
        const float rot = ph ? (y[i] * cs.x + pr * cs.y) : (y[i] * cs.x - pr * cs.y);
        o[i] = (lat ? rot : y[i]) * QS_M;
      }
      if (sub < 4) *(uint4*)(QM + ((size_t)(b * 8 + head) * KP + pos) * 96 + 64 + sub * 8) = pack8(o);
    }
    {
      float v[8];
      unpack8(*(const uint4*)(KV + (size_t)r * 1024 + head * 128 + sub * 8), v);
      float ss = 0.f;
#pragma unroll
      for (int i = 0; i < 8; i++) ss += v[i] * v[i];
      ss += __shfl_xor(ss, 1); ss += __shfl_xor(ss, 2); ss += __shfl_xor(ss, 4);
      const float rstd = rsqrtf(ss * (1.f / 64.f) + 1e-6f);
      float o[8];
#pragma unroll
      for (int i = 0; i < 8; i++) o[i] = v[i] * rstd * nopeg[64 + sub * 8 + i];
      *(uint4*)(KN + ((size_t)(b * 8 + head) * KP + pos) * 64 + sub * 8) = pack8(o);
    }
  }
  for (int task0 = (cx.bid * 8 + w) * 2; task0 < (MT / 64) * 64; task0 += cx.nb * 16) {
    uint4 raw[2]; u16* dst[2];
#pragma unroll
    for (int j = 0; j < 2; j++) {
      const int task = task0 + j;
      const int tt = task >> 6, c = task & 63;
      const int r = tt * 64 + lane;
      int b, pos, prow, pcol; bool lat;
      row_info(r, b, pos, lat, prow, pcol);
      const int head = c >> 3, dv0 = (c & 7) * 8;
      raw[j] = *(const uint4*)(KV + (size_t)r * 1024 + head * 128 + 64 + dv0);
      dst[j] = VMT + ((size_t)(b * 8 + head) * 64 + dv0) * KPS + vperm16(pos);
    }
#pragma unroll
    for (int j = 0; j < 2; j++) {
      dst[j][0 * (size_t)KPS] = (u16)(raw[j].x & 0xffffu); dst[j][1 * (size_t)KPS] = (u16)(raw[j].x >> 16);
      dst[j][2 * (size_t)KPS] = (u16)(raw[j].y & 0xffffu); dst[j][3 * (size_t)KPS] = (u16)(raw[j].y >> 16);
      dst[j][4 * (size_t)KPS] = (u16)(raw[j].z & 0xffffu); dst[j][5 * (size_t)KPS] = (u16)(raw[j].z >> 16);
      dst[j][6 * (size_t)KPS] = (u16)(raw[j].w & 0xffffu); dst[j][7 * (size_t)KPS] = (u16)(raw[j].w >> 16);
    }
  }
}

template <int KIND>
DI void attn_unit(const Ctx cx, const Params& p, char* smem, int b, int hd, int q0, int nkeys) {
  constexpr int DQK = KIND == 0 ? 64 : 96;
  constexpr int DV = KIND == 0 ? 128 : 64;
  constexpr int NKK = DQK / 16;
  constexpr int NVT = DV / 32;
  constexpr int KSTR = DQK * 2 + 16;
  constexpr int VSTR = 144;
  constexpr int VOFF = 64 * 208;
  constexpr int STAGE = 64 * 208 + 128 * 144;
  const float c2 = (KIND == 0 ? 0.125f : 0.10206207261596575f) * 1.4426950408889634f;
  char* ws = p.ws;
  const int tid = cx.tid, lane = tid & 63, w = tid >> 6, l32 = lane & 31, h = lane >> 5;
  const u16 *Qbase, *Kbase, *KRbase = nullptr, *Vbase;
  if (KIND == 0) {
    Qbase = (const u16*)(ws + OFF_QD) + ((size_t)(b * 8 + hd) * KP + q0) * 64;
    Kbase = (const u16*)(ws + OFF_KD) + (size_t)(b * 8 + hd) * KP * 64;
    Vbase = (const u16*)(ws + OFF_VDT) + (size_t)(b * 4 + (hd >> 1)) * 128 * KPS;
  } else {
    Qbase = (const u16*)(ws + OFF_QM) + ((size_t)(b * 8 + hd) * KP + q0) * 96;
    Kbase = (const u16*)(ws + OFF_KN) + (size_t)(b * 8 + hd) * KP * 64;
    KRbase = (const u16*)(ws + OFF_KR) + (size_t)b * KP * 32;
    Vbase = (const u16*)(ws + OFF_VMT) + (size_t)(b * 8 + hd) * 64 * KPS;
  }
  bf16x8 qf[NKK];
#pragma unroll
  for (int kk = 0; kk < NKK; kk++) qf[kk] = *(const bf16x8*)(Qbase + (size_t)(w * 32 + l32) * DQK + kk * 16 + h * 8);
  f32x16 o[NVT];
#pragma unroll
  for (int i = 0; i < NVT; i++)
#pragma unroll
    for (int r = 0; r < 16; r++) o[i][r] = 0.f;
  float lsum = 0.f;
  f32x16 negm;
#pragma unroll
  for (int r = 0; r < 16; r++) negm[r] = 0.f;

  const int srow = tid >> 3, sch = tid & 7;
  uint4 rk0, rk1 = make_uint4(0, 0, 0, 0), rv0, rv1 = make_uint4(0, 0, 0, 0);
  const int nkt = nkeys >> 6;
#define ATT_GLOAD(kt_)                                                                                  \
  {                                                                                                     \
    const int key0 = (kt_) * 64;                                                                        \
    rk0 = *(const uint4*)(Kbase + (size_t)(key0 + srow) * 64 + sch * 8);                                \
    if (KIND == 1) { if (tid < 256) rk1 = *(const uint4*)(KRbase + (size_t)(key0 + (tid >> 2)) * 32 + (tid & 3) * 8); } \
    rv0 = *(const uint4*)(Vbase + (size_t)srow * KPS + key0 + sch * 8);                                  \
    if (KIND == 0) rv1 = *(const uint4*)(Vbase + (size_t)(srow + 64) * KPS + key0 + sch * 8);            \
  }
#define ATT_SSTORE(st_)                                                                                 \
  {                                                                                                     \
    char* Ks_ = smem + (st_) * STAGE; char* Vs_ = Ks_ + VOFF;                                           \
    *(uint4*)(Ks_ + srow * KSTR + sch * 16) = rk0;                                                      \
    if (KIND == 1) { if (tid < 256) *(uint4*)(Ks_ + (tid >> 2) * KSTR + 128 + (tid & 3) * 16) = rk1; }  \
    *(uint4*)(Vs_ + srow * VSTR + sch * 16) = rv0;                                                      \
    if (KIND == 0) *(uint4*)(Vs_ + (srow + 64) * VSTR + sch * 16) = rv1;                                \
  }
  ATT_GLOAD(0);
  ATT_SSTORE(0);
  __syncthreads();
  for (int kt = 0; kt < nkt; kt++) {
    const int cur = kt & 1;
    if (kt + 1 < nkt) ATT_GLOAD(kt + 1);
    __builtin_amdgcn_sched_barrier(0);
    const char* Ks = smem + cur * STAGE + l32 * KSTR + h * 16;
    const char* Vs = smem + cur * STAGE + VOFF + l32 * VSTR + h * 16;
    f32x16 st0, st1;
    {
      bf16x8 ka[NKK], kb[NKK];
#pragma unroll
      for (int kk = 0; kk < NKK; kk++) {
        ka[kk] = *(const bf16x8*)(Ks + kk * 32);
        kb[kk] = *(const bf16x8*)(Ks + 32 * KSTR + kk * 32);
      }
      __builtin_amdgcn_s_setprio(1);
      st0 = MFMA32(ka[0], qf[0], negm);
      st1 = MFMA32(kb[0], qf[0], negm);
#pragma unroll
      for (int kk = 1; kk < NKK; kk++) {
        st0 = MFMA32(ka[kk], qf[kk], st0);
        st1 = MFMA32(kb[kk], qf[kk], st1);
      }
      __builtin_amdgcn_sched_group_barrier(0x100, 2 * NKK, 0);
      __builtin_amdgcn_sched_group_barrier(0x008, 2 * NKK, 0);
      __builtin_amdgcn_s_setprio(0);
    }
    __builtin_amdgcn_sched_barrier(0);
    bf16x8 vf[2][4];
#pragma unroll
    for (int ks = 0; ks < 4; ks++) vf[0][ks] = *(const bf16x8*)(Vs + ks * 32);
    if (kt == 0) {
      float mt = st0[0];
#pragma unroll
      for (int r = 1; r < 16; r++) mt = fmaxf(mt, st0[r]);
#pragma unroll
      for (int r = 0; r < 16; r++) mt = fmaxf(mt, st1[r]);
      mt = fmaxf(mt, __shfl_xor(mt, 32));
#pragma unroll
      for (int r = 0; r < 16; r++) { st0[r] -= mt; st1[r] -= mt; negm[r] -= mt; }
    }
    float ps = 0.f;
#pragma unroll
    for (int r = 0; r < 16; r++) {
      st0[r] = __builtin_amdgcn_exp2f(st0[r]);
      st1[r] = __builtin_amdgcn_exp2f(st1[r]);
      ps += st0[r] + st1[r];
    }
    if (__any(ps > 256.f)) {
      float pm = st0[0];
#pragma unroll
      for (int r = 1; r < 16; r++) pm = fmaxf(pm, st0[r]);
#pragma unroll
      for (int r = 0; r < 16; r++) pm = fmaxf(pm, st1[r]);
      pm = fmaxf(pm, __shfl_xor(pm, 32));
      const float d = fmaxf(__builtin_amdgcn_logf(pm), 0.f);
      const float alpha = __builtin_amdgcn_exp2f(-d);
      lsum *= alpha; ps *= alpha;
#pragma unroll
      for (int i = 0; i < NVT; i++)
#pragma unroll
        for (int r = 0; r < 16; r++) o[i][r] *= alpha;
#pragma unroll
      for (int r = 0; r < 16; r++) { st0[r] *= alpha; st1[r] *= alpha; negm[r] -= d; }
    }
    lsum += ps;
    bf16x8 pf[4];
    {
      u32x4 t0, t1, t2, t3;
      t0.x = pk2(st0[0], st0[1]); t0.y = pk2(st0[2], st0[3]); t0.z = pk2(st0[4], st0[5]); t0.w = pk2(st0[6], st0[7]);
      t1.x = pk2(st0[8], st0[9]); t1.y = pk2(st0[10], st0[11]); t1.z = pk2(st0[12], st0[13]); t1.w = pk2(st0[14], st0[15]);
      t2.x = pk2(st1[0], st1[1]); t2.y = pk2(st1[2], st1[3]); t2.z = pk2(st1[4], st1[5]); t2.w = pk2(st1[6], st1[7]);
      t3.x = pk2(st1[8], st1[9]); t3.y = pk2(st1[10], st1[11]); t3.z = pk2(st1[12], st1[13]); t3.w = pk2(st1[14], st1[15]);
      pf[0] = __builtin_bit_cast(bf16x8, t0); pf[1] = __builtin_bit_cast(bf16x8, t1);
      pf[2] = __builtin_bit_cast(bf16x8, t2); pf[3] = __builtin_bit_cast(bf16x8, t3);
    }
    __builtin_amdgcn_sched_barrier(0);
    __builtin_amdgcn_s_setprio(1);
#pragma unroll
    for (int i = 0; i < NVT; i++) {
      if (i + 1 < NVT) {
#pragma unroll
        for (int ks = 0; ks < 4; ks++) vf[(i + 1) & 1][ks] = *(const bf16x8*)(Vs + (i + 1) * 32 * VSTR + ks * 32);
      }
#pragma unroll
      for (int ks = 0; ks < 4; ks++) o[i] = MFMA32(vf[i & 1][ks], pf[ks], o[i]);
    }
#pragma unroll
    for (int i = 0; i < NVT; i++) {
      if (i + 1 < NVT) __builtin_amdgcn_sched_group_barrier(0x100, 4, 0);
      __builtin_amdgcn_sched_group_barrier(0x008, 4, 0);
    }
    __builtin_amdgcn_s_setprio(0);
    __builtin_amdgcn_sched_barrier(0);
    if (kt + 1 < nkt) ATT_SSTORE(cur ^ 1);
    __syncthreads();
  }
#undef ATT_GLOAD
#undef ATT_SSTORE
  const float lt = lsum + __shfl_xor(lsum, 32);
  const float inv = 1.f / lt;
  const int qpos = q0 + w * 32 + l32;
  const size_t row = (qpos >= 256) ? ((size_t)b * 8192 + (qpos - 256)) : ((size_t)ML + b * 256 + qpos);
  u16* O;
  if (KIND == 0) O = (u16*)(ws + OFF_BIG) + (size_t)(hd & 1) * MT * 512 + row * 512 + (hd >> 1) * 128;
  else O = (u16*)(ws + OFF_XN) + row * XNS + 512 + hd * 64;
#pragma unroll
  for (int i = 0; i < NVT; i++)
#pragma unroll
    for (int rg = 0; rg < 4; rg++) {
      uint2 v;
      v.x = pk2(o[i][4 * rg] * inv, o[i][4 * rg + 1] * inv);
      v.y = pk2(o[i][4 * rg + 2] * inv, o[i][4 * rg + 3] * inv);
      *(uint2*)(O + i * 32 + 8 * rg + 4 * h) = v;
    }
}

DI void phase_attn(const Ctx cx, const Params& p, char* smem) {
  const int nb = cx.nb;
  const int vb = (nb % 8 == 0) ? ((cx.bid & 7) * (nb >> 3) + (cx.bid >> 3)) : cx.bid;
#pragma unroll 1
  for (int U = vb; U < 4096 + 128; U += nb) {
    int kind, b, hd, q0, nkeys;
    if (U < 4096) {
      const int bh = U >> 5, qb = U & 31;
      kind = bh >> 6; b = (bh & 63) >> 3; hd = bh & 7; q0 = 256 + qb * 256; nkeys = KP;
    } else {
      const int u2 = U - 4096;
      kind = u2 >> 6; b = (u2 & 63) >> 3; hd = u2 & 7; q0 = 0; nkeys = CTXL;
    }
    if (kind == 0) attn_unit<0>(cx, p, smem, b, hd, q0, nkeys);
    else attn_unit<1>(cx, p, smem, b, hd, q0, nkeys);
  }
}

DI void phase_merge(const Ctx cx, const Params& p, int ai, float lam_init) {
  const int lane = cx.tid & 63, w = cx.tid >> 6;
  const float* dl = p.dlam + ai * 256;
  float s1 = 0.f, s2 = 0.f;
  for (int i = 0; i < 64; i++) { s1 += dl[i] * dl[64 + i]; s2 += dl[128 + i] * dl[192 + i]; }
  const float lam = expf(s1) - expf(s2) + lam_init;
  const u16* O0 = (const u16*)(p.ws + OFF_BIG);
  const u16* O1 = O0 + (size_t)MT * 512;
  u16* XN = (u16*)(p.ws + OFF_XN);
  const float* sg = p.subln_g + ai * 128;
  const float post = 1.f - lam_init;
  for (int r = cx.bid * 8 + w; r < MT; r += cx.nb * 8) {
    float a[8], bb[8], d[8];
    unpack8(*(const uint4*)(O0 + (size_t)r * 512 + lane * 8), a);
    unpack8(*(const uint4*)(O1 + (size_t)r * 512 + lane * 8), bb);
    float ss = 0.f;
#pragma unroll
    for (int i = 0; i < 8; i++) { d[i] = a[i] - lam * bb[i]; ss += d[i] * d[i]; }
    ss += __shfl_xor(ss, 1); ss += __shfl_xor(ss, 2); ss += __shfl_xor(ss, 4); ss += __shfl_xor(ss, 8);
    const float rstd = rsqrtf(ss * (1.f / 128.f) + 1e-6f);
    float o[8];
#pragma unroll
    for (int i = 0; i < 8; i++) o[i] = d[i] * rstd * sg[(lane & 15) * 8 + i] * post;
    *(uint4*)(XN + (size_t)r * XNS + lane * 8) = pack8(o);
  }
}

DI void phase_pooldiff(const Ctx cx, const Params& p, int nrows) {
  const int lane = cx.tid & 63, w = cx.tid >> 6;
  const u16* XN = (const u16*)(p.ws + OFF_XN);
  u16* PD = (u16*)(p.ws + OFF_BIG);
  const int ntask = (nrows >> 4) * 2;
  for (int task = cx.bid * 8 + w; task < ntask; task += cx.nb * 8) {
    const int r0 = (task >> 1) * 16, k = task & 1;
    int base, t0, L;
    if (r0 < ML) { base = r0 & ~8191; t0 = r0 & 8191; L = SEQ; } else { base = ML + ((r0 - ML) & ~255); t0 = (r0 - ML) & 255; L = CTXL; }
    const int ch = (k * 64 + lane) * 8;
    const int hw = 1 << (ch >> 8);
    const u16* col = XN + (size_t)base * XNS + ch;
    u16* out = PD + (size_t)base * XNS + ch;
    float S[8];
#pragma unroll
    for (int j = 0; j < 8; j++) S[j] = 0.f;
    for (int s = max(t0 - hw, 0); s < min(t0 + hw, L); s++) {
      float v[8];
      unpack8(*(const uint4*)(col + (size_t)s * XNS), v);
#pragma unroll
      for (int j = 0; j < 8; j++) S[j] += v[j];
    }
#pragma unroll 4
    for (int i = 0; i < 16; i++) {
      const int t = t0 + i, tin = t + hw, tout = t - hw;
      const uint4 rme = *(const uint4*)(col + (size_t)t * XNS);
      const uint4 rin = *(const uint4*)(col + (size_t)min(tin, L - 1) * XNS);
      const uint4 rout = *(const uint4*)(col + (size_t)max(tout, 0) * XNS);
      const float fin = (tin < L) ? 1.f : 0.f, fout = (tout >= 0) ? 1.f : 0.f;
      const float invc = 1.f / (float)(min(tin, L) - max(tout, 0));
      float me[8], vi[8], vo[8], o[8];
      unpack8(rme, me); unpack8(rin, vi); unpack8(rout, vo);
#pragma unroll
      for (int j = 0; j < 8; j++) { o[j] = S[j] * invc - me[j]; S[j] += fin * vi[j] - fout * vo[j]; }
      *(uint4*)(out + (size_t)t * XNS) = pack8(o);
    }
  }
}

DI void grid_barrier(unsigned* ctr, unsigned target) {
  __syncthreads();
  if (threadIdx.x == 0) {
    __builtin_amdgcn_fence(__ATOMIC_RELEASE, "agent");
    asm volatile("s_waitcnt vmcnt(0)" ::: "memory");
    __hip_atomic_fetch_add(ctr, 1u, __ATOMIC_RELAXED, __HIP_MEMORY_SCOPE_AGENT);
    while (__hip_atomic_load(ctr, __ATOMIC_RELAXED, __HIP_MEMORY_SCOPE_AGENT) < target) __builtin_amdgcn_s_sleep(1);
    __builtin_amdgcn_fence(__ATOMIC_ACQUIRE, "agent");
    asm volatile("s_waitcnt vmcnt(0)" ::: "memory");
  }
  __syncthreads();
}

__global__ void __launch_bounds__(NTHR) fwd_megakernel(Params p) {
  extern __shared__ __attribute__((aligned(16))) char smem[];
  cg::grid_group grid = cg::this_grid();
  const float* MOD = (const float*)(p.ws + OFF_MOD);
  float* XC = (float*)(p.ws + OFF_XC);
  u16* XN = (u16*)(p.ws + OFF_XN);
  u16* BIG = (u16*)(p.ws + OFF_BIG);

  {
    Ctx cx; cx.tid = threadIdx.x; cx.bid = blockIdx.x; cx.nb = gridDim.x;
    phase_prep(cx, p, smem);
  }
  grid.sync();

  unsigned* bar = (unsigned*)(p.ws + OFF_BAR);
  unsigned nbar = 0;
#pragma unroll 1
  for (int ps = 0; ps < 4 * 15; ps++) {
    Ctx cx; cx.tid = threadIdx.x; cx.bid = blockIdx.x; cx.nb = gridDim.x;
    asm volatile("" : "+v"(cx.tid), "+s"(cx.bid), "+s"(cx.nb));
    const int layer = ps / 15, step = ps % 15;
    const bool even = (layer & 1) == 0;
    const int nMt = (layer < 3) ? 264 : 256;
    const int nrows = nMt * 256;
    const int ai = layer >> 1;
    const float* xsl = (layer == 0 && step < 3) ? p.x : p.out;
    const float* xsc = (layer == 0 && step < 3) ? p.ctx : XC;
    const float* modl = MOD + (size_t)layer * 9 * 9216;
    if (!even && step >= 6 && step <= 11) continue;
    GemmArgs g{};
    int gk = -1;
    g.nMt = nMt; g.xsl = xsl; g.xsc = xsc; g.xdl = p.out; g.xdc = XC; g.mod = modl; g.coef = 1.f; g.colscale = nullptr;
    switch (step) {
      case 0: convert_ffn_weights(cx, p, layer, smem); phase_norm(cx, p, xsl, xsc, nrows, layer, 0); break;
      case 1: case 13:
        gk = EPI_GU; g.A = XN; g.lda = XNS; g.W = (const u16*)(p.ws + OFF_WGU) + (step == 13 ? (size_t)5632 * XNS : 0); g.ldw = XNS;
        g.K = 1024; g.nNt = 22; g.outb = BIG; g.ldo = HS; g.ncols = 5632; break;
      case 2: case 14:
        gk = EPI_RES; g.A = BIG; g.lda = HS; g.W = (const u16*)(p.ws + OFF_WD) + (step == 14 ? (size_t)1024 * HS : 0); g.ldw = HS;
        g.K = DFF; g.nNt = 4; g.gidx = (step == 14) ? 8 : 2; g.coef = 0.5f; break;
      case 3: phase_norm(cx, p, xsl, xsc, nrows, layer, 1); break;
      case 4:
        if (even) {
          gk = EPI_RAW; g.A = XN; g.lda = XNS; g.W = (const u16*)(p.ws + OFF_WIN) + (size_t)ai * INWP * XNS; g.ldw = XNS;
          g.K = 1024; g.nNt = 9; g.outb = BIG; g.ldo = INW; g.ncols = INW;
        } else {
          phase_pooldiff(cx, p, nrows);
        }
        break;
      case 5:
        if (even) {
          phase_post1(cx, p, ai);
        } else {
          gk = EPI_RES; g.A = BIG; g.lda = XNS; g.a_koff = 256; g.W = (const u16*)(p.ws + OFF_WPOOL) + (size_t)ai * 1024 * 256; g.ldw = 256;
          g.K = 256; g.nNt = 4; g.gidx = 5; g.colscale = p.pool_scale + (size_t)ai * 1024;
        }
        break;
      case 6:
        gk = EPI_RAW; g.A = XN; g.lda = 384; g.W = (const u16*)(p.ws + OFF_WQB) + (size_t)ai * 768 * 384; g.ldw = 384;
        g.K = 384; g.nNt = 3; g.outb = BIG; g.ldo = 768; g.ncols = 768; break;
      case 7:
        gk = EPI_RAW; g.A = XN + (size_t)MT * 384; g.lda = 256; g.W = (const u16*)(p.ws + OFF_WKVB) + (size_t)ai * 1024 * 256; g.ldw = 256;
        g.K = 256; g.nNt = 4; g.outb = BIG + (size_t)MT * 768; g.ldo = 1024; g.ncols = 1024; break;
      case 8: phase_post2(cx, p, ai); break;
      case 9: phase_attn(cx, p, smem); break;
      case 10: phase_merge(cx, p, ai, layer == 0 ? 0.2f : 0.47071301831856f); break;
      case 11:
        gk = EPI_RES; g.A = XN; g.lda = XNS; g.W = (const u16*)(p.ws + OFF_WOUT) + (size_t)ai * 1024 * XNS; g.ldw = XNS;
        g.K = 1024; g.nNt = 4; g.gidx = 5; break;
      case 12: phase_norm(cx, p, xsl, xsc, nrows, layer, 2); break;
    }
    if (gk >= 0) gemm_phase(cx, g, gk, smem);
    if (ps != 4 * 15 - 1) { nbar++; grid_barrier(bar, nbar * gridDim.x); }
  }
}

extern "C" void kernel_launch(void* const* d_in, const int* in_sizes, int n_in, void* d_out, int out_size, void* d_ws,
                              size_t ws_size, hipStream_t stream) {
  static int grid_blocks = 0;
  if (grid_blocks == 0) {
    if (n_in != 23 || ws_size < WS_NEED) {
      fprintf(stderr, "kernel_launch: need 23 inputs and %zu bytes of workspace, got %d / %zu\n", (size_t)WS_NEED, n_in, ws_size);
      grid_blocks = -1;
      return;
    }
    int dev = 0, cus = 0, per_cu = 0;
    hipGetDevice(&dev);
    hipDeviceGetAttribute(&cus, hipDeviceAttributeMultiprocessorCount, dev);
    if (hipFuncSetAttribute((const void*)fwd_megakernel, hipFuncAttributeMaxDynamicSharedMemorySize, LDS_BYTES) != hipSuccess) {
      fprintf(stderr, "kernel_launch: hipFuncSetAttribute failed\n");
      grid_blocks = -1;
      return;
    }
    hipOccupancyMaxActiveBlocksPerMultiprocessor(&per_cu, (const void*)fwd_megakernel, NTHR, LDS_BYTES);
    if (per_cu < 1) per_cu = 1;
    (void)hipGetLastError();
    grid_blocks = cus * 1;
  }
  if (grid_blocks < 0) return;
  (void)hipMemsetAsync((char*)d_ws + OFF_BAR, 0, 256, stream);
  Params p{};
  const float** pp = (const float**)&p;
  for (int i = 0; i < 23; i++) pp[i] = (const float*)d_in[i];
  p.out = (float*)d_out;
  p.ws = (char*)d_ws;
  void* args[] = {&p};
  hipError_t e = hipLaunchCooperativeKernel((const void*)fwd_megakernel, dim3(grid_blocks), dim3(NTHR), args, LDS_BYTES, stream);
  if (e != hipSuccess) fprintf(stderr, "cooperative launch failed: %s (grid %d)\n", hipGetErrorString(e), grid_blocks);
}
```

```cpp
#include <hip/hip_runtime.h>
#include <hip/hip_cooperative_groups.h>
#include <cstdio>
namespace cg = cooperative_groups;

typedef unsigned short u16;
typedef __attribute__((ext_vector_type(8))) short bf16x8;
typedef __attribute__((ext_vector_type(16))) float f32x16;
typedef __attribute__((ext_vector_type(2))) float f32x2;
typedef __attribute__((ext_vector_type(4))) float f32x4;
typedef __attribute__((ext_vector_type(4))) unsigned u32x4;
typedef __attribute__((ext_vector_type(2))) __bf16 bf16x2_t;
#define DI __device__ __forceinline__
#define MFMA32(a, b, c) __builtin_amdgcn_mfma_f32_32x32x16_bf16((a), (b), (c), 0, 0, 0)

constexpr int NB = 8, SEQ = 8192, DM = 1024, CTXL = 256, DFF = 2816;
constexpr int ML = NB * SEQ, MC = NB * CTXL, MT = ML + MC, KP = SEQ + CTXL;
constexpr int INW = 2208, INWP = 2304;
constexpr int XNS = 1088, HS = 2880, KPS = 8512;
constexpr int NTHR = 512;
constexpr float QS_D = 0.125f * 1.4426950408889634f;
constexpr float QS_M = 0.10206207261596575f * 1.4426950408889634f;
constexpr int LDS_BYTES = 147456;

constexpr size_t al(size_t x) { return (x + 255) & ~size_t(255); }
constexpr size_t OFF_MOD = 0;
constexpr size_t OFF_ROPED = al(OFF_MOD + (size_t)4 * 9 * 9216 * 4);
constexpr size_t OFF_ROPEM = al(OFF_ROPED + 128 * 16 * 8);
constexpr size_t OFF_XC = al(OFF_ROPEM + 128 * 8 * 8);
constexpr size_t OFF_WIN = al(OFF_XC + (size_t)MC * DM * 4);
constexpr size_t OFF_WQB = al(OFF_WIN + (size_t)2 * INWP * XNS * 2);
constexpr size_t OFF_WKVB = al(OFF_WQB + (size_t)2 * 768 * 384 * 2);
constexpr size_t OFF_WOUT = al(OFF_WKVB + (size_t)2 * 1024 * 256 * 2);
constexpr size_t OFF_WPOOL = al(OFF_WOUT + (size_t)2 * 1024 * XNS * 2);
constexpr size_t OFF_WGU = al(OFF_WPOOL + (size_t)2 * 1024 * 256 * 2);
constexpr size_t OFF_WD = al(OFF_WGU + (size_t)2 * 5632 * XNS * 2);
constexpr size_t OFF_XN = al(OFF_WD + (size_t)2 * 1024 * HS * 2);
constexpr size_t OFF_BIG = al(OFF_XN + (size_t)MT * XNS * 2);
constexpr size_t SZ_HD = (size_t)NB * 8 * KP * 64 * 2;
constexpr size_t OFF_QD = al(OFF_BIG + (size_t)MT * HS * 2);
constexpr size_t OFF_KD = al(OFF_QD + SZ_HD);
constexpr size_t OFF_VDT = al(OFF_KD + SZ_HD);
constexpr size_t SZ_VT = (size_t)NB * 8 * 64 * KPS * 2;
constexpr size_t OFF_QM = al(OFF_VDT + SZ_VT);
constexpr size_t OFF_KN = al(OFF_QM + (size_t)NB * 8 * KP * 96 * 2);
constexpr size_t OFF_KR = al(OFF_KN + SZ_HD);
constexpr size_t OFF_VMT = al(OFF_KR + (size_t)NB * KP * 32 * 2);
constexpr size_t OFF_BAR = al(OFF_VMT + SZ_VT);
constexpr size_t WS_NEED = al(OFF_BAR + 256);

struct Ctx { int tid, bid, nb; };

struct Params {
  const float *x, *c, *ctx, *c_ctx, *mod_w, *mod_b, *norm_g, *wg, *wu, *wd, *w_in, *qk_g, *dlam, *subln_g,
      *q_a_g, *w_q_b, *kv_a_g, *w_kv_b, *nope_g, *rope_g, *w_out, *pool_w, *pool_scale;
  float* out;
  char* ws;
};

DI float bf2f(u16 v) { return __uint_as_float(((unsigned)v) << 16); }
DI unsigned pk2(float a, float b) {
  f32x2 v = {a, b};
  bf16x2_t r = __builtin_convertvector(v, bf16x2_t);
  return __builtin_bit_cast(unsigned, r);
}
DI void unpack8(uint4 v, float* f) {
  f[0] = __uint_as_float(v.x << 16); f[1] = __uint_as_float(v.x & 0xffff0000u);
  f[2] = __uint_as_float(v.y << 16); f[3] = __uint_as_float(v.y & 0xffff0000u);
  f[4] = __uint_as_float(v.z << 16); f[5] = __uint_as_float(v.z & 0xffff0000u);
  f[6] = __uint_as_float(v.w << 16); f[7] = __uint_as_float(v.w & 0xffff0000u);
}
DI uint4 pack8(const float* f) {
  uint4 o; o.x = pk2(f[0], f[1]); o.y = pk2(f[2], f[3]); o.z = pk2(f[4], f[5]); o.w = pk2(f[6], f[7]);
  return o;
}
DI int vperm16(int pos) { return (pos & ~12) | ((pos & 4) << 1) | ((pos & 8) >> 1); }

DI void tr_convert(const Ctx cx, const float* __restrict__ src, int K, int N, u16* __restrict__ dst, int ldd, int mode, float* tile) {
  const int tid = cx.tid;
  const int nkt = K / 64, nnt = (N + 63) / 64;
  const int total = nkt * nnt;
  for (int u = cx.bid; u < total; u += 2 * cx.nb) {
    float4 v[2][2];
#pragma unroll
    for (int t = 0; t < 2; t++) {
      const int uu = u + t * cx.nb;
      const int kt = uu / nnt, nt = uu % nnt;
      const int k0 = kt * 64, n0 = nt * 64;
#pragma unroll
      for (int i = 0; i < 2; i++) {
        const int k = (tid >> 4) + 32 * i, n4 = (tid & 15) * 4;
        v[t][i] = make_float4(0.f, 0.f, 0.f, 0.f);
        if (uu < total && n0 + n4 < N) v[t][i] = *(const float4*)(src + (size_t)(k0 + k) * N + n0 + n4);
      }
    }
#pragma unroll
    for (int t = 0; t < 2; t++)
#pragma unroll
      for (int i = 0; i < 2; i++) {
        const int k = (tid >> 4) + 32 * i, n4 = (tid & 15) * 4;
        float* tl = tile + t * (64 * 65);
        tl[k * 65 + n4 + 0] = v[t][i].x; tl[k * 65 + n4 + 1] = v[t][i].y; tl[k * 65 + n4 + 2] = v[t][i].z; tl[k * 65 + n4 + 3] = v[t][i].w;
      }
    __syncthreads();
#pragma unroll
    for (int t = 0; t < 2; t++) {
      const int uu = u + t * cx.nb;
      const int kt = uu / nnt, nt = uu % nnt;
      const int k0 = kt * 64, n0 = nt * 64;
      const int n = tid >> 3, kc = (tid & 7) * 8;
      if (uu < total && n0 + n < N) {
        const float* tl = tile + t * (64 * 65);
        float f[8];
#pragma unroll
        for (int j = 0; j < 8; j++) f[j] = tl[(kc + j) * 65 + n];
        const int j = n0 + n;
        const int row = (mode == 0) ? j : ((j >> 5) * 64 + (j & 31) + (mode == 2 ? 32 : 0));
        *(uint4*)(dst + (size_t)row * ldd + k0 + kc) = pack8(f);
      }
    }
    __syncthreads();
  }
}

DI void phase_prep(const Ctx cx, const Params& p, char* smem) {
  const int tid = cx.tid, lane = tid & 63, w = tid >> 6;
  float* lds = (float*)smem;
  float* MOD = (float*)(p.ws + OFF_MOD);
  if (cx.bid == cx.nb - 1) {
    float2* RD = (float2*)(p.ws + OFF_ROPED);
    float2* RM = (float2*)(p.ws + OFF_ROPEM);
    for (int i = tid; i < 128 * 16 + 128 * 8; i += NTHR) {
      int pos, j, q; float2* dst;
      if (i < 128 * 16) { pos = i >> 4; j = i & 15; q = 16; dst = RD + i; }
      else { int ii = i - 128 * 16; pos = ii >> 3; j = ii & 7; q = 8; dst = RM + ii; }
      const float freq = exp2f(-(float)j / (float)q * 13.287712379549449f);
      const float ang = (float)pos * freq;
      const float n = rintf(ang * 0.15915494309189535f);
      float r = fmaf(-n, 6.2831854820251465f, ang);
      r = fmaf(-n, -1.7484555e-7f, r);
      *dst = make_float2(__cosf(r), __sinf(r));
    }
  }
  {
    float* sil = lds;
    float* red = lds + 9 * 1024;
    for (int i = tid; i < 9 * 1024; i += NTHR) {
      const int s = i >> 10, k = i & 1023;
      const float v = (s < 8) ? p.c[s * 1024 + k] : p.c_ctx[k];
      sil[i] = v / (1.f + __expf(-v));
    }
    __syncthreads();
    for (int u = cx.bid; u < 4 * 144; u += cx.nb) {
      const int layer = u / 144, cgp = u % 144;
      const int col = cgp * 64 + lane;
      const float* wp = p.mod_w + (size_t)layer * 1024 * 9216 + col;
      float acc[9];
#pragma unroll
      for (int s = 0; s < 9; s++) acc[s] = 0.f;
      const int kb = w * 128;
#pragma unroll 8
      for (int k = kb; k < kb + 128; k++) {
        const float wv = wp[(size_t)k * 9216];
#pragma unroll
        for (int s = 0; s < 9; s++) acc[s] = fmaf(sil[s * 1024 + k], wv, acc[s]);
      }
#pragma unroll
      for (int s = 0; s < 9; s++) red[(w * 9 + s) * 64 + lane] = acc[s];
      __syncthreads();
      for (int i = tid; i < 576; i += NTHR) {
        const int s = i >> 6, cc = i & 63;
        float t = 0.f;
#pragma unroll
        for (int ww = 0; ww < 8; ww++) t += red[(ww * 9 + s) * 64 + cc];
        const int c2 = cgp * 64 + cc;
        MOD[((size_t)layer * 9 + s) * 9216 + c2] = t + p.mod_b[layer * 9216 + c2];
      }
      __syncthreads();
    }
  }
#pragma unroll 1
  for (int t = 0; t < 16; t++) {
    const int i = t >> 3, j = t & 7;
    const float* s; int K, N, ldd; u16* d;
    if (j == 0) { s = p.w_in + (size_t)i * 1024 * INW; K = 1024; N = INW; d = (u16*)(p.ws + OFF_WIN) + (size_t)i * INWP * XNS; ldd = XNS; }
    else if (j == 1) { s = p.w_q_b + (size_t)i * 384 * 768; K = 384; N = 768; d = (u16*)(p.ws + OFF_WQB) + (size_t)i * 768 * 384; ldd = 384; }
    else if (j == 2) { s = p.w_kv_b + (size_t)i * 256 * 1024; K = 256; N = 1024; d = (u16*)(p.ws + OFF_WKVB) + (size_t)i * 1024 * 256; ldd = 256; }
    else if (j == 3) { s = p.w_out + (size_t)i * 1024 * 1024; K = 1024; N = 1024; d = (u16*)(p.ws + OFF_WOUT) + (size_t)i * 1024 * XNS; ldd = XNS; }
    else { const int g = j - 4; s = p.pool_w + (size_t)(i * 4 + g) * 65536; K = 256; N = 256; d = (u16*)(p.ws + OFF_WPOOL) + (size_t)i * 1024 * 256 + (size_t)g * 65536; ldd = 256; }
    tr_convert(cx, s, K, N, d, ldd, 0, lds);
  }
}

DI void convert_ffn_weights(const Ctx cx, const Params& p, int layer, char* smem) {
  float* lds = (float*)smem;
#pragma unroll 1
  for (int t = 0; t < 6; t++) {
    const int f = t / 3, kind = t % 3;
    const size_t mi = (size_t)(layer * 2 + f);
    const float* s; int K, N, ldd, mode; u16* d;
    if (kind == 0) { s = p.wg + mi * 1024 * DFF; K = 1024; N = DFF; d = (u16*)(p.ws + OFF_WGU) + (size_t)f * 5632 * XNS; ldd = XNS; mode = 1; }
    else if (kind == 1) { s = p.wu + mi * 1024 * DFF; K = 1024; N = DFF; d = (u16*)(p.ws + OFF_WGU) + (size_t)f * 5632 * XNS; ldd = XNS; mode = 2; }
    else { s = p.wd + mi * DFF * 1024; K = DFF; N = 1024; d = (u16*)(p.ws + OFF_WD) + (size_t)f * 1024 * HS; ldd = HS; mode = 0; }
    tr_convert(cx, s, K, N, d, ldd, mode, lds);
  }
}

DI float wave_sum(float v) {
#pragma unroll
  for (int m = 32; m >= 1; m >>= 1) v += __shfl_xor(v, m);
  return v;
}
DI void phase_norm(const Ctx cx, const Params& p, const float* xl, const float* xc, int nrows, int layer, int sub) {
  const int lane = cx.tid & 63, w = cx.tid >> 6;
  const float* g = p.norm_g + (size_t)(layer * 3 + sub) * 1024;
  const float* MOD = (const float*)(p.ws + OFF_MOD);
  u16* XN = (u16*)(p.ws + OFF_XN);
  constexpr int NR = 4;
  for (int r0 = (cx.bid * 8 + w) * NR; r0 < nrows; r0 += cx.nb * 8 * NR) {
    const float* xr[NR]; int s[NR];
#pragma unroll
    for (int j = 0; j < NR; j++) {
      const int r = r0 + j;
      if (r < ML) { xr[j] = xl + (size_t)r * 1024; s[j] = r >> 13; } else { xr[j] = xc + (size_t)(r - ML) * 1024; s[j] = 8; }
    }
    float4 v[NR][4]; float ss[NR];
#pragma unroll
    for (int j = 0; j < NR; j++)
#pragma unroll
      for (int i = 0; i < 4; i++) v[j][i] = *(const float4*)(xr[j] + (i * 64 + lane) * 4);
#pragma unroll
    for (int j = 0; j < NR; j++) {
      ss[j] = 0.f;
#pragma unroll
      for (int i = 0; i < 4; i++) ss[j] += v[j][i].x * v[j][i].x + v[j][i].y * v[j][i].y + v[j][i].z * v[j][i].z + v[j][i].w * v[j][i].w;
      ss[j] = wave_sum(ss[j]);
    }
    float4 gs[4], shv[4];
    {
      const float* md = MOD + ((size_t)layer * 9 + s[0]) * 9216 + (size_t)(3 * sub) * 1024;
#pragma unroll
      for (int i = 0; i < 4; i++) {
        const int col = (i * 64 + lane) * 4;
        const float4 g4 = *(const float4*)(g + col);
        const float4 sc = *(const float4*)(md + 1024 + col);
        shv[i] = *(const float4*)(md + col);
        gs[i] = make_float4(g4.x * (1.f + sc.x), g4.y * (1.f + sc.y), g4.z * (1.f + sc.z), g4.w * (1.f + sc.w));
      }
    }
#pragma unroll
    for (int j = 0; j < NR; j++) {
      const float rstd = rsqrtf(ss[j] * (1.f / 1024.f) + 1e-6f);
#pragma unroll
      for (int i = 0; i < 4; i++) {
        const int col = (i * 64 + lane) * 4;
        const float y0 = v[j][i].x * rstd * gs[i].x + shv[i].x;
        const float y1 = v[j][i].y * rstd * gs[i].y + shv[i].y;
        const float y2 = v[j][i].z * rstd * gs[i].z + shv[i].z;
        const float y3 = v[j][i].w * rstd * gs[i].w + shv[i].w;
        uint2 o; o.x = pk2(y0, y1); o.y = pk2(y2, y3);
        *(uint2*)(XN + (size_t)(r0 + j) * XNS + col) = o;
      }
    }
  }
}

enum { EPI_GU = 0, EPI_RES = 1, EPI_RAW = 2 };
struct GemmArgs {
  const u16* A; int lda; int a_koff;
  const u16* W; int ldw;
  int K, nMt, nNt;
  u16* outb; int ldo; int ncols;
  const float* xsl; const float* xsc; float* xdl; float* xdc;
  const float* mod; int gidx; float coef; const float* colscale;
};

DI void gemm_phase(const Ctx cx, const GemmArgs& g, const int EPI, char* smem) {
  const int tid = cx.tid, lane = tid & 63, w = tid >> 6, wm = w >> 2, wn = w & 3;
  const int l16 = lane & 15, kg = lane >> 4;
  const int ntiles = g.nMt * g.nNt;
  const int nk = g.K >> 6;
  const int nb = cx.nb;
  const int vb = (nb % 8 == 0) ? ((cx.bid & 7) * (nb >> 3) + (cx.bid >> 3)) : cx.bid;
  const int srow = tid >> 3, sch = tid & 7;
  const int wsl = (sch ^ ((srow >> 1) & 7)) * 16;
  const int swr = l16 >> 1;
  const int ro0 = ((0 + kg) ^ swr) * 16, ro1 = ((4 + kg) ^ swr) * 16;
  u32x4 ra[4], rb[4];
  bool primed = false;
#pragma unroll 1
  for (int T = vb; T < ntiles; T += nb) {
    const int grp = T / (4 * g.nNt), within = T % (4 * g.nNt);
    const int mt = grp * 4 + (within & 3), nt = within >> 2;
    const u16* Ag = g.A + (size_t)(mt * 256 + srow) * g.lda + (size_t)nt * g.a_koff + sch * 8;
    const u16* Wg = g.W + (size_t)(nt * 256 + srow) * g.ldw + sch * 8;
    long dA = 0, dW = 0;
    {
      const int Tn = T + nb;
      if (Tn < ntiles) {
        const int grpn = Tn / (4 * g.nNt), withinn = Tn % (4 * g.nNt);
        const int mtn = grpn * 4 + (withinn & 3), ntn = withinn >> 2;
        dA = (long)(mtn - mt) * 256 * g.lda + (long)(ntn - nt) * g.a_koff;
        dW = (long)(ntn - nt) * 256 * g.ldw;
      }
    }
    f32x4 acc[8][4];
#pragma unroll
    for (int mi = 0; mi < 8; mi++)
#pragma unroll
      for (int ni = 0; ni < 4; ni++)
#pragma unroll
        for (int r = 0; r < 4; r++) acc[mi][ni][r] = 0.f;
    if (!primed) {
      primed = true;
#pragma unroll
      for (int i = 0; i < 4; i++) {
        ra[i] = *(const u32x4*)(Ag + (size_t)(64 * i) * g.lda);
        rb[i] = *(const u32x4*)(Wg + (size_t)(64 * i) * g.ldw);
      }
#pragma unroll
      for (int i = 0; i < 4; i++) {
        *(u32x4*)(smem + (srow + 64 * i) * 128 + wsl) = ra[i];
        *(u32x4*)(smem + 32768 + (srow + 64 * i) * 128 + wsl) = rb[i];
      }
#pragma unroll
      for (int i = 0; i < 4; i++) {
        ra[i] = *(const u32x4*)(Ag + (size_t)(64 * i) * g.lda + 64);
        rb[i] = *(const u32x4*)(Wg + (size_t)(64 * i) * g.ldw + 64);
      }
      __syncthreads();
    }
    __builtin_amdgcn_s_waitcnt(0x0F70);
#pragma unroll 1
    for (int kt = 0; kt < nk; kt++) {
      const int cur = kt & 1;
      const bool nx = (kt + 2 >= nk);
      const long k2a = nx ? dA + (long)(kt + 2 - nk) * 64 : (long)(kt + 2) * 64;
      const long k2w = nx ? dW + (long)(kt + 2 - nk) * 64 : (long)(kt + 2) * 64;
      const char* As = smem + cur * 65536 + (wm * 128 + l16) * 128;
      const char* Bs = smem + cur * 65536 + 32768 + (wn * 64 + l16) * 128;
      char* dA_ = smem + (cur ^ 1) * 65536 + srow * 128 + wsl;
      bf16x8 bf[2][4], af[2][4];
#pragma unroll
      for (int ni = 0; ni < 4; ni++) bf[0][ni] = *(const bf16x8*)(Bs + ni * 2048 + ro0);
#pragma unroll
      for (int mi = 0; mi < 4; mi++) af[0][mi] = *(const bf16x8*)(As + mi * 2048 + ro0);
#pragma unroll
      for (int q = 0; q < 4; q++) {
        const int s = q >> 1, hm = q & 1;
        if (q == 0) {
#pragma unroll
          for (int mi = 0; mi < 4; mi++) af[1][mi] = *(const bf16x8*)(As + (4 + mi) * 2048 + ro0);
#pragma unroll
          for (int ni = 0; ni < 4; ni++) bf[1][ni] = *(const bf16x8*)(Bs + ni * 2048 + ro1);
        } else if (q == 1) {
#pragma unroll
          for (int mi = 0; mi < 4; mi++) af[0][mi] = *(const bf16x8*)(As + mi * 2048 + ro1);
        } else if (q == 2) {
#pragma unroll
          for (int mi = 0; mi < 4; mi++) af[1][mi] = *(const bf16x8*)(As + (4 + mi) * 2048 + ro1);
        }
        if (q >= 1) {
#pragma unroll
          for (int i = (q == 3 ? 2 : q - 1); i < (q == 3 ? 4 : q); i++) {
            *(u32x4*)(dA_ + 64 * i * 128) = ra[i];
            *(u32x4*)(dA_ + 32768 + 64 * i * 128) = rb[i];
          }
#pragma unroll
          for (int i = (q == 3 ? 2 : q - 1); i < (q == 3 ? 4 : q); i++) {
            ra[i] = *(const u32x4*)(Ag + (long)(64 * i) * g.lda + k2a);
            rb[i] = *(const u32x4*)(Wg + (long)(64 * i) * g.ldw + k2w);
          }
        }
#pragma unroll
        for (int mi = 0; mi < 4; mi++)
#pragma unroll
          for (int ni = 0; ni < 4; ni++)
            acc[hm * 4 + mi][ni] = __builtin_amdgcn_mfma_f32_16x16x32_bf16(af[hm][mi], bf[s][ni], acc[hm * 4 + mi][ni], 0, 0, 0);
      }
      __builtin_amdgcn_sched_group_barrier(0x100, 8, 0);
#pragma unroll
      for (int j = 0; j < 8; j++) { __builtin_amdgcn_sched_group_barrier(0x008, 2, 0); __builtin_amdgcn_sched_group_barrier(0x100, 1, 0); }
#pragma unroll
      for (int qq = 0; qq < 2; qq++) {
#pragma unroll
        for (int j = 0; j < 4; j++) { __builtin_amdgcn_sched_group_barrier(0x008, 2, 0); __builtin_amdgcn_sched_group_barrier(0x100, 1, 0); }
#pragma unroll
        for (int j = 0; j < 2; j++) { __builtin_amdgcn_sched_group_barrier(0x008, 2, 0); __builtin_amdgcn_sched_group_barrier(0x200, 1, 0); }
#pragma unroll
        for (int j = 0; j < 2; j++) { __builtin_amdgcn_sched_group_barrier(0x008, 2, 0); __builtin_amdgcn_sched_group_barrier(0x020, 1, 0); }
      }
#pragma unroll
      for (int j = 0; j < 4; j++) { __builtin_amdgcn_sched_group_barrier(0x008, 2, 0); __builtin_amdgcn_sched_group_barrier(0x200, 1, 0); }
#pragma unroll
      for (int j = 0; j < 4; j++) { __builtin_amdgcn_sched_group_barrier(0x008, 2, 0); __builtin_amdgcn_sched_group_barrier(0x020, 1, 0); }
      __syncthreads();
    }
    const int m0 = mt * 256 + wm * 128, n0 = nt * 256 + wn * 64;
    if (EPI == EPI_GU) {
      u16* ob = g.outb + (size_t)(m0 + 4 * kg) * g.ldo + (n0 >> 1) + l16;
      const size_t st16 = (size_t)16 * g.ldo;
#pragma unroll
      for (int mi = 0; mi < 8; mi++) {
#pragma unroll
        for (int ni = 0; ni < 2; ni++)
#pragma unroll
          for (int r = 0; r < 4; r++) {
            const float gt = acc[mi][ni][r], up = acc[mi][ni + 2][r];
            const float y = gt / (1.f + __expf(-gt)) * up;
            ob[(size_t)r * g.ldo + ni * 16] = (u16)(pk2(y, 0.f) & 0xffffu);
          }
        ob += st16;
        asm volatile("" : "+v"(ob) : : "memory");
      }
    } else if (EPI == EPI_RAW) {
      u16* ob = g.outb + (size_t)(m0 + 4 * kg) * g.ldo + n0 + l16;
      const size_t st16 = (size_t)16 * g.ldo;
#pragma unroll
      for (int mi = 0; mi < 8; mi++) {
#pragma unroll
        for (int ni = 0; ni < 4; ni++) {
          if (n0 + ni * 16 + l16 < g.ncols) {
#pragma unroll
            for (int r = 0; r < 4; r++) ob[(size_t)r * g.ldo + ni * 16] = (u16)(pk2(acc[mi][ni][r], 0.f) & 0xffffu);
          }
        }
        ob += st16;
        asm volatile("" : "+v"(ob) : : "memory");
      }
    } else {
      const float* xs; float* xd; int s; int mb;
      if (mt < 256) { xs = g.xsl; xd = g.xdl; s = mt >> 5; mb = m0; }
      else { xs = g.xsc; xd = g.xdc; s = 8; mb = m0 - ML; }
      const float* modrow = g.mod + (size_t)s * 9216 + (size_t)g.gidx * 1024;
      float gm[4];
#pragma unroll
      for (int ni = 0; ni < 4; ni++) {
        const int n = n0 + ni * 16 + l16;
        gm[ni] = g.coef * modrow[n] * (g.colscale ? g.colscale[n] : 1.f);
      }
      const size_t base = (size_t)(mb + 4 * kg) * 1024 + n0 + l16;
      const float* xsp = xs + base;
      float* xdp = xd + base;
#pragma unroll
      for (int mi = 0; mi < 8; mi++) {
        float t[16];
#pragma unroll
        for (int ni = 0; ni < 4; ni++)
#pragma unroll
          for (int r = 0; r < 4; r++) t[ni * 4 + r] = xsp[r * 1024 + ni * 16];
#pragma unroll
        for (int ni = 0; ni < 4; ni++)
#pragma unroll
          for (int r = 0; r < 4; r++) xdp[r * 1024 + ni * 16] = t[ni * 4 + r] + gm[ni] * acc[mi][ni][r];
        xsp += 16 * 1024; xdp += 16 * 1024;
        asm volatile("" : "+v"(xsp), "+v"(xdp) : : "memory");
      }
    }
  }
}

DI void row_info(int r, int& b, int& pos, bool& lat, int& prow, int& pcol) {
  if (r < ML) { b = r >> 13; const int t = r & 8191; pos = 256 + t; lat = true; prow = t >> 6; pcol = t & 63; }
  else { const int rr = r - ML; b = rr >> 8; pos = rr & 255; lat = false; prow = 0; pcol = 0; }
}

DI void phase_post1(const Ctx cx, const Params& p, int ai) {
  const int lane = cx.tid & 63, w = cx.tid >> 6;
  const u16* RAW = (const u16*)(p.ws + OFF_BIG);
  u16* QD = (u16*)(p.ws + OFF_QD); u16* KD = (u16*)(p.ws + OFF_KD); u16* VDT = (u16*)(p.ws + OFF_VDT);
  u16* CQN = (u16*)(p.ws + OFF_XN); u16* CKVN = CQN + (size_t)MT * 384;
  u16* KR = (u16*)(p.ws + OFF_KR);
  const float2* RD = (const float2*)(p.ws + OFF_ROPED);
  const float2* RM = (const float2*)(p.ws + OFF_ROPEM);
  const float* qkg = p.qk_g + ai * 128;
  const float* qag = p.q_a_g + ai * 384;
  const float* kvag = p.kv_a_g + ai * 256;
  const float* ropeg = p.rope_g + ai * 64 + 32;
  for (int r = cx.bid * 8 + w; r < MT; r += cx.nb * 8) {
    int b, pos, prow, pcol; bool lat;
    row_info(r, b, pos, lat, prow, pcol);
    const u16* rr = RAW + (size_t)r * INW;
    const int li = lane & 7, sh = lane >> 3;
#pragma unroll
    for (int which = 0; which < 2; which++) {
      float v[8];
      unpack8(*(const uint4*)(rr + which * 512 + lane * 8), v);
      float ss = 0.f;
#pragma unroll
      for (int i = 0; i < 8; i++) ss += v[i] * v[i];
      ss += __shfl_xor(ss, 1); ss += __shfl_xor(ss, 2); ss += __shfl_xor(ss, 4);
      const float rstd = rsqrtf(ss * (1.f / 64.f) + 1e-6f);
      float y[8];
#pragma unroll
      for (int i = 0; i < 8; i++) y[i] = v[i] * rstd * qkg[which * 64 + li * 8 + i];
      float o[8];
      const int a = li >> 2, ph = (li >> 1) & 1;
      const int pa = a ? pcol : prow;
#pragma unroll
      for (int i = 0; i < 8; i++) {
        const float pr = __shfl_xor(y[i], 2);
        const float2 cs = RD[pa * 16 + (li & 1) * 8 + i];
        const float rot = ph ? (y[i] * cs.x + pr * cs.y) : (y[i] * cs.x - pr * cs.y);
        o[i] = (lat ? rot : y[i]) * (which ? 1.f : QS_D);
      }
      u16* dst = (which ? KD : QD) + ((size_t)(b * 8 + sh) * KP + pos) * 64 + li * 8;
      *(uint4*)dst = pack8(o);
    }
    {
      float v[8];
      uint4 raw = make_uint4(0, 0, 0, 0);
      if (lane < 48) raw = *(const uint4*)(rr + 1536 + lane * 8);
      unpack8(raw, v);
      float ss = 0.f;
#pragma unroll
      for (int i = 0; i < 8; i++) ss += v[i] * v[i];
      ss = wave_sum(ss);
      const float rstd = rsqrtf(ss * (1.f / 384.f) + 1e-6f);
      if (lane < 48) {
        float o[8];
#pragma unroll
        for (int i = 0; i < 8; i++) o[i] = v[i] * rstd * qag[lane * 8 + i];
        *(uint4*)(CQN + (size_t)r * 384 + lane * 8) = pack8(o);
      }
    }
    {
      float v[8];
      uint4 raw = make_uint4(0, 0, 0, 0);
      if (lane < 32) raw = *(const uint4*)(rr + 1920 + lane * 8);
      unpack8(raw, v);
      float ss = 0.f;
#pragma unroll
      for (int i = 0; i < 8; i++) ss += v[i] * v[i];
      ss = wave_sum(ss);
      const float rstd = rsqrtf(ss * (1.f / 256.f) + 1e-6f);
      if (lane < 32) {
        float o[8];
#pragma unroll
        for (int i = 0; i < 8; i++) o[i] = v[i] * rstd * kvag[lane * 8 + i];
        *(uint4*)(CKVN + (size_t)r * 256 + lane * 8) = pack8(o);
      }
    }
    {
      float v[8];
      uint4 raw = make_uint4(0, 0, 0, 0);
      if (lane < 4) raw = *(const uint4*)(rr + 2176 + lane * 8);
      unpack8(raw, v);
      float ss = 0.f;
#pragma unroll
      for (int i = 0; i < 8; i++) ss += v[i] * v[i];
      ss += __shfl_xor(ss, 1); ss += __shfl_xor(ss, 2);
      const float rstd = rsqrtf(ss * (1.f / 32.f) + 1e-6f);
      float y[8], o[8];
      const int l4 = lane & 3;
#pragma unroll
      for (int i = 0; i < 8; i++) y[i] = v[i] * rstd * ropeg[l4 * 8 + i];
      const int a = l4 >> 1, ph = l4 & 1;
      const int pa = a ? pcol : prow;
#pragma unroll
      for (int i = 0; i < 8; i++) {
        const float pr = __shfl_xor(y[i], 1);
        const float2 cs = RM[pa * 8 + i];
        const float rot = ph ? (y[i] * cs.x + pr * cs.y) : (y[i] * cs.x - pr * cs.y);
        o[i] = lat ? rot : y[i];
      }
      if (lane < 4) *(uint4*)(KR + ((size_t)b * KP + pos) * 32 + lane * 8) = pack8(o);
    }
  }
  for (int task0 = (cx.bid * 8 + w) * 2; task0 < (MT / 64) * 64; task0 += cx.nb * 16) {
    uint4 raw[2]; u16* dst[2];
#pragma unroll
    for (int j = 0; j < 2; j++) {
      const int task = task0 + j;
      const int tt = task >> 6, c = task & 63;
      const int r = tt * 64 + lane;
      int b, pos, prow, pcol; bool lat;
      row_info(r, b, pos, lat, prow, pcol);
      raw[j] = *(const uint4*)(RAW + (size_t)r * INW + 1024 + c * 8);
      const int head = c >> 4, dv0 = (c & 15) * 8;
      dst[j] = VDT + ((size_t)(b * 4 + head) * 128 + dv0) * KPS + vperm16(pos);
    }
#pragma unroll
    for (int j = 0; j < 2; j++) {
      dst[j][0 * (size_t)KPS] = (u16)(raw[j].x & 0xffffu); dst[j][1 * (size_t)KPS] = (u16)(raw[j].x >> 16);
      dst[j][2 * (size_t)KPS] = (u16)(raw[j].y & 0xffffu); dst[j][3 * (size_t)KPS] = (u16)(raw[j].y >> 16);
      dst[j][4 * (size_t)KPS] = (u16)(raw[j].z & 0xffffu); dst[j][5 * (size_t)KPS] = (u16)(raw[j].z >> 16);
      dst[j][6 * (size_t)KPS] = (u16)(raw[j].w & 0xffffu); dst[j][7 * (size_t)KPS] = (u16)(raw[j].w >> 16);
    }
  }
}

DI void phase_post2(const Ctx cx, const Params& p, int ai) {
  const int lane = cx.tid & 63, w = cx.tid >> 6;
  const u16* MQ = (const u16*)(p.ws + OFF_BIG);
  const u16* KV = MQ + (size_t)MT * 768;
  u16* QM = (u16*)(p.ws + OFF_QM); u16* KN = (u16*)(p.ws + OFF_KN); u16* VMT = (u16*)(p.ws + OFF_VMT);
  const float2* RM = (const float2*)(p.ws + OFF_ROPEM);
  const float* nopeg = p.nope_g + ai * 128;
  const float* ropeg = p.rope_g + ai * 64;
  for (int r = cx.bid * 8 + w; r < MT; r += cx.nb * 8) {
    int b, pos, prow, pcol; bool lat;
    row_info(r, b, pos, lat, prow, pcol);
    const int head = lane >> 3, sub = lane & 7;
    {
      float v[8];
      unpack8(*(const uint4*)(MQ + (size_t)r * 768 + head * 96 + sub * 8), v);
      float ss = 0.f;
#pragma unroll
      for (int i = 0; i < 8; i++) ss += v[i] * v[i];
      ss += __shfl_xor(ss, 1); ss += __shfl_xor(ss, 2); ss += __shfl_xor(ss, 4);
      const float rstd = rsqrtf(ss * (1.f / 64.f) + 1e-6f);
      float o[8];
#pragma unroll
      for (int i = 0; i < 8; i++) o[i] = v[i] * rstd * nopeg[sub * 8 + i] * QS_M;
      *(uint4*)(QM + ((size_t)(b * 8 + head) * KP + pos) * 96 + sub * 8) = pack8(o);
    }
    {
      float v[8];
      uint4 raw = make_uint4(0, 0, 0, 0);
      if (sub < 4) raw = *(const uint4*)(MQ + (size_t)r * 768 + head * 96 + 64 + sub * 8);
      unpack8(raw, v);
      float ss = 0.f;
#pragma unroll
      for (int i = 0; i < 8; i++) ss += v[i] * v[i];
      ss += __shfl_xor(ss, 1); ss += __shfl_xor(ss, 2);
      const float rstd = rsqrtf(ss * (1.f / 32.f) + 1e-6f);
      float y[8], o[8];
      const int s4 = sub & 3;
#pragma unroll
      for (int i = 0; i < 8; i++) y[i] = v[i] * rstd * ropeg[s4 * 8 + i];
      const int a = s4 >> 1, ph = s4 & 1;
      const int pa = a ? pcol : prow;
#pragma unroll
      for (int i = 0; i < 8; i++) {
        const float pr = __shfl_xor(y[i], 1);
        const float2 cs = RM[pa * 8 + i];
        const float rot = ph ? (y[i] * cs.x + pr * cs.y) : (y[i] * cs.x - pr * cs.y);
        o[i] = (lat ? rot : y[i]) * QS_M;
      }
      if (sub < 4) *(uint4*)(QM + ((size_t)(b * 8 + head) * KP + pos) * 96 + 64 + sub * 8) = pack8(o);
    }
    {
      float v[8];
      unpack8(*(const uint4*)(KV + (size_t)r * 1024 + head * 128 + sub * 8), v);
      float ss = 0.f;
#pragma unroll
      for (int i = 0; i < 8; i++) ss += v[i] * v[i];
      ss += __shfl_xor(ss, 1); ss += __shfl_xor(ss, 2); ss += __shfl_xor(ss, 4);
      const float rstd = rsqrtf(ss * (1.f / 64.f) + 1e-6f);
      float o[8];
#pragma unroll
      for (int i = 0; i < 8; i++) o[i] = v[i] * rstd * nopeg[64 + sub * 8 + i];
      *(uint4*)(KN + ((size_t)(b * 8 + head) * KP + pos) * 64 + sub * 8) = pack8(o);
    }
  }
  for (int task0 = (cx.bid * 8 + w) * 2; task0 < (MT / 64) * 64; task0 += cx.nb * 16) {
    uint4 raw[2]; u16* dst[2];
#pragma unroll
    for (int j = 0; j < 2; j++) {
      const int task = task0 + j;
      const int tt = task >> 6, c = task & 63;
      const int r = tt * 64 + lane;
      int b, pos, prow, pcol; bool lat;
      row_info(r, b, pos, lat, prow, pcol);
      const int head = c >> 3, dv0 = (c & 7) * 8;
      raw[j] = *(const uint4*)(KV + (size_t)r * 1024 + head * 128 + 64 + dv0);
      dst[j] = VMT + ((size_t)(b * 8 + head) * 64 + dv0) * KPS + vperm16(pos);
    }
#pragma unroll
    for (int j = 0; j < 2; j++) {
      dst[j][0 * (size_t)KPS] = (u16)(raw[j].x & 0xffffu); dst[j][1 * (size_t)KPS] = (u16)(raw[j].x >> 16);
      dst[j][2 * (size_t)KPS] = (u16)(raw[j].y & 0xffffu); dst[j][3 * (size_t)KPS] = (u16)(raw[j].y >> 16);
      dst[j][4 * (size_t)KPS] = (u16)(raw[j].z & 0xffffu); dst[j][5 * (size_t)KPS] = (u16)(raw[j].z >> 16);
      dst[j][6 * (size_t)KPS] = (u16)(raw[j].w & 0xffffu); dst[j][7 * (size_t)KPS] = (u16)(raw[j].w >> 16);
    }
  }
}

template <int KIND>
DI void attn_unit(const Ctx cx, const Params& p, char* smem, int b, int hd, int q0, int nkeys) {
  constexpr int DQK = KIND == 0 ? 64 : 96;
  constexpr int DV = KIND == 0 ? 128 : 64;
  constexpr int NKK = DQK / 16;
  constexpr int NVT = DV / 32;
  constexpr int KSTR = DQK * 2 + 16;
  constexpr int VSTR = 144;
  constexpr int VOFF = 64 * 208;
  constexpr int STAGE = 64 * 208 + 128 * 144;
  const float c2 = (KIND == 0 ? 0.125f : 0.10206207261596575f) * 1.4426950408889634f;
  char* ws = p.ws;
  const int tid = cx.tid, lane = tid & 63, w = tid >> 6, l32 = lane & 31, h = lane >> 5;
  const u16 *Qbase, *Kbase, *KRbase = nullptr, *Vbase;
  if (KIND == 0) {
    Qbase = (const u16*)(ws + OFF_QD) + ((size_t)(b * 8 + hd) * KP + q0) * 64;
    Kbase = (const u16*)(ws + OFF_KD) + (size_t)(b * 8 + hd) * KP * 64;
    Vbase = (const u16*)(ws + OFF_VDT) + (size_t)(b * 4 + (hd >> 1)) * 128 * KPS;
  } else {
    Qbase = (const u16*)(ws + OFF_QM) + ((size_t)(b * 8 + hd) * KP + q0) * 96;
    Kbase = (const u16*)(ws + OFF_KN) + (size_t)(b * 8 + hd) * KP * 64;
    KRbase = (const u16*)(ws + OFF_KR) + (size_t)b * KP * 32;
    Vbase = (const u16*)(ws + OFF_VMT) + (size_t)(b * 8 + hd) * 64 * KPS;
  }
  bf16x8 qf[NKK];
#pragma unroll
  for (int kk = 0; kk < NKK; kk++) qf[kk] = *(const bf16x8*)(Qbase + (size_t)(w * 32 + l32) * DQK + kk * 16 + h * 8);
  f32x16 o[NVT];
#pragma unroll
  for (int i = 0; i < NVT; i++)
#pragma unroll
    for (int r = 0; r < 16; r++) o[i][r] = 0.f;
  float lsum = 0.f;
  f32x16 negm;
#pragma unroll
  for (int r = 0; r < 16; r++) negm[r] = 0.f;

  const int srow = tid >> 3, sch = tid & 7;
  uint4 rk0, rk1 = make_uint4(0, 0, 0, 0), rv0, rv1 = make_uint4(0, 0, 0, 0);
  const int nkt = nkeys >> 6;
#define ATT_GLOAD(kt_)                                                                                  \
  {                                                                                                     \
    const int key0 = (kt_) * 64;                                                                        \
    rk0 = *(const uint4*)(Kbase + (size_t)(key0 + srow) * 64 + sch * 8);                                \
    if (KIND == 1) { if (tid < 256) rk1 = *(const uint4*)(KRbase + (size_t)(key0 + (tid >> 2)) * 32 + (tid & 3) * 8); } \
    rv0 = *(const uint4*)(Vbase + (size_t)srow * KPS + key0 + sch * 8);                                  \
    if (KIND == 0) rv1 = *(const uint4*)(Vbase + (size_t)(srow + 64) * KPS + key0 + sch * 8);            \
  }
#define ATT_SSTORE(st_)                                                                                 \
  {                                                                                                     \
    char* Ks_ = smem + (st_) * STAGE; char* Vs_ = Ks_ + VOFF;                                           \
    *(uint4*)(Ks_ + srow * KSTR + sch * 16) = rk0;                                                      \
    if (KIND == 1) { if (tid < 256) *(uint4*)(Ks_ + (tid >> 2) * KSTR + 128 + (tid & 3) * 16) = rk1; }  \
    *(uint4*)(Vs_ + srow * VSTR + sch * 16) = rv0;                                                      \
    if (KIND == 0) *(uint4*)(Vs_ + (srow + 64) * VSTR + sch * 16) = rv1;                                \
  }
  ATT_GLOAD(0);
  ATT_SSTORE(0);
  __syncthreads();
  for (int kt = 0; kt < nkt; kt++) {
    const int cur = kt & 1;
    if (kt + 1 < nkt) ATT_GLOAD(kt + 1);
    __builtin_amdgcn_sched_barrier(0);
    const char* Ks = smem + cur * STAGE + l32 * KSTR + h * 16;
    const char* Vs = smem + cur * STAGE + VOFF + l32 * VSTR + h * 16;
    f32x16 st0, st1;
    {
      bf16x8 ka[NKK], kb[NKK];
#pragma unroll
      for (int kk = 0; kk < NKK; kk++) {
        ka[kk] = *(const bf16x8*)(Ks + kk * 32);
        kb[kk] = *(const bf16x8*)(Ks + 32 * KSTR + kk * 32);
      }
      __builtin_amdgcn_s_setprio(1);
      st0 = MFMA32(ka[0], qf[0], negm);
      st1 = MFMA32(kb[0], qf[0], negm);
#pragma unroll
      for (int kk = 1; kk < NKK; kk++) {
        st0 = MFMA32(ka[kk], qf[kk], st0);
        st1 = MFMA32(kb[kk], qf[kk], st1);
      }
      __builtin_amdgcn_sched_group_barrier(0x100, 2 * NKK, 0);
      __builtin_amdgcn_sched_group_barrier(0x008, 2 * NKK, 0);
      __builtin_amdgcn_s_setprio(0);
    }
    __builtin_amdgcn_sched_barrier(0);
    bf16x8 vf[2][4];
#pragma unroll
    for (int ks = 0; ks < 4; ks++) vf[0][ks] = *(const bf16x8*)(Vs + ks * 32);
    if (kt == 0) {
      float mt = st0[0];
#pragma unroll
      for (int r = 1; r < 16; r++) mt = fmaxf(mt, st0[r]);
#pragma unroll
      for (int r = 0; r < 16; r++) mt = fmaxf(mt, st1[r]);
      mt = fmaxf(mt, __shfl_xor(mt, 32));
#pragma unroll
      for (int r = 0; r < 16; r++) { st0[r] -= mt; st1[r] -= mt; negm[r] -= mt; }
    }
    float ps = 0.f;
#pragma unroll
    for (int r = 0; r < 16; r++) {
      st0[r] = __builtin_amdgcn_exp2f(st0[r]);
      st1[r] = __builtin_amdgcn_exp2f(st1[r]);
      ps += st0[r] + st1[r];
    }
    if (__any(ps > 256.f)) {
      float pm = st0[0];
#pragma unroll
      for (int r = 1; r < 16; r++) pm = fmaxf(pm, st0[r]);
#pragma unroll
      for (int r = 0; r < 16; r++) pm = fmaxf(pm, st1[r]);
      pm = fmaxf(pm, __shfl_xor(pm, 32));
      const float d = fmaxf(__builtin_amdgcn_logf(pm), 0.f);
      const float alpha = __builtin_amdgcn_exp2f(-d);
      lsum *= alpha; ps *= alpha;
#pragma unroll
      for (int i = 0; i < NVT; i++)
#pragma unroll
        for (int r = 0; r < 16; r++) o[i][r] *= alpha;
#pragma unroll
      for (int r = 0; r < 16; r++) { st0[r] *= alpha; st1[r] *= alpha; negm[r] -= d; }
    }
    lsum += ps;
    bf16x8 pf[4];
    {
      u32x4 t0, t1, t2, t3;
      t0.x = pk2(st0[0], st0[1]); t0.y = pk2(st0[2], st0[3]); t0.z = pk2(st0[4], st0[5]); t0.w = pk2(st0[6], st0[7]);
      t1.x = pk2(st0[8], st0[9]); t1.y = pk2(st0[10], st0[11]); t1.z = pk2(st0[12], st0[13]); t1.w = pk2(st0[14], st0[15]);
      t2.x = pk2(st1[0], st1[1]); t2.y = pk2(st1[2], st1[3]); t2.z = pk2(st1[4], st1[5]); t2.w = pk2(st1[6], st1[7]);
      t3.x = pk2(st1[8], st1[9]); t3.y = pk2(st1[10], st1[11]); t3.z = pk2(st1[12], st1[13]); t3.w = pk2(st1[14], st1[15]);
      pf[0] = __builtin_bit_cast(bf16x8, t0); pf[1] = __builtin_bit_cast(bf16x8, t1);
      pf[2] = __builtin_bit_cast(bf16x8, t2); pf[3] = __builtin_bit_cast(bf16x8, t3);
    }
    __builtin_amdgcn_sched_barrier(0);
    __builtin_amdgcn_s_setprio(1);
#pragma unroll
    for (int i = 0; i < NVT; i++) {
      if (i + 1 < NVT) {
#pragma unroll
        for (int ks = 0; ks < 4; ks++) vf[(i + 1) & 1][ks] = *(const bf16x8*)(Vs + (i + 1) * 32 * VSTR + ks * 32);
      }
#pragma unroll
      for (int ks = 0; ks < 4; ks++) o[i] = MFMA32(vf[i & 1][ks], pf[ks], o[i]);
    }
#pragma unroll
    for (int i = 0; i < NVT; i++) {
      if (i + 1 < NVT) __builtin_amdgcn_sched_group_barrier(0x100, 4, 0);
      __builtin_amdgcn_sched_group_barrier(0x008, 4, 0);
    }
    __builtin_amdgcn_s_setprio(0);
    __builtin_amdgcn_sched_barrier(0);
    if (kt + 1 < nkt) ATT_SSTORE(cur ^ 1);
    __syncthreads();
  }
#undef ATT_GLOAD
#undef ATT_SSTORE
  const float lt = lsum + __shfl_xor(lsum, 32);
  const float inv = 1.f / lt;
  const int qpos = q0 + w * 32 + l32;
  const size_t row = (qpos >= 256) ? ((size_t)b * 8192 + (qpos - 256)) : ((size_t)ML + b * 256 + qpos);
  u16* O;
  if (KIND == 0) O = (u16*)(ws + OFF_BIG) + (size_t)(hd & 1) * MT * 512 + row * 512 + (hd >> 1) * 128;
  else O = (u16*)(ws + OFF_XN) + row * XNS + 512 + hd * 64;
#pragma unroll
  for (int i = 0; i < NVT; i++)
#pragma unroll
    for (int rg = 0; rg < 4; rg++) {
      uint2 v;
      v.x = pk2(o[i][4 * rg] * inv, o[i][4 * rg + 1] * inv);
      v.y = pk2(o[i][4 * rg + 2] * inv, o[i][4 * rg + 3] * inv);
      *(uint2*)(O + i * 32 + 8 * rg + 4 * h) = v;
    }
}

DI void phase_attn(const Ctx cx, const Params& p, char* smem) {
  const int nb = cx.nb;
  const int vb = (nb % 8 == 0) ? ((cx.bid & 7) * (nb >> 3) + (cx.bid >> 3)) : cx.bid;
#pragma unroll 1
  for (int U = vb; U < 4096 + 128; U += nb) {
    int kind, b, hd, q0, nkeys;
    if (U < 4096) {
      const int bh = U >> 5, qb = U & 31;
      kind = bh >> 6; b = (bh & 63) >> 3; hd = bh & 7; q0 = 256 + qb * 256; nkeys = KP;
    } else {
      const int u2 = U - 4096;
      kind = u2 >> 6; b = (u2 & 63) >> 3; hd = u2 & 7; q0 = 0; nkeys = CTXL;
    }
    if (kind == 0) attn_unit<0>(cx, p, smem, b, hd, q0, nkeys);
    else attn_unit<1>(cx, p, smem, b, hd, q0, nkeys);
  }
}

DI void phase_merge(const Ctx cx, const Params& p, int ai, float lam_init) {
  const int lane = cx.tid & 63, w = cx.tid >> 6;
  const float* dl = p.dlam + ai * 256;
  float s1 = 0.f, s2 = 0.f;
  for (int i = 0; i < 64; i++) { s1 += dl[i] * dl[64 + i]; s2 += dl[128 + i] * dl[192 + i]; }
  const float lam = expf(s1) - expf(s2) + lam_init;
  const u16* O0 = (const u16*)(p.ws + OFF_BIG);
  const u16* O1 = O0 + (size_t)MT * 512;
  u16* XN = (u16*)(p.ws + OFF_XN);
  const float* sg = p.subln_g + ai * 128;
  const float post = 1.f - lam_init;
  for (int r = cx.bid * 8 + w; r < MT; r += cx.nb * 8) {
    float a[8], bb[8], d[8];
    unpack8(*(const uint4*)(O0 + (size_t)r * 512 + lane * 8), a);
    unpack8(*(const uint4*)(O1 + (size_t)r * 512 + lane * 8), bb);
    float ss = 0.f;
#pragma unroll
    for (int i = 0; i < 8; i++) { d[i] = a[i] - lam * bb[i]; ss += d[i] * d[i]; }
    ss += __shfl_xor(ss, 1); ss += __shfl_xor(ss, 2); ss += __shfl_xor(ss, 4); ss += __shfl_xor(ss, 8);
    const float rstd = rsqrtf(ss * (1.f / 128.f) + 1e-6f);
    float o[8];
#pragma unroll
    for (int i = 0; i < 8; i++) o[i] = d[i] * rstd * sg[(lane & 15) * 8 + i] * post;
    *(uint4*)(XN + (size_t)r * XNS + lane * 8) = pack8(o);
  }
}

DI void phase_pooldiff(const Ctx cx, const Params& p, int nrows) {
  const int lane = cx.tid & 63, w = cx.tid >> 6;
  const u16* XN = (const u16*)(p.ws + OFF_XN);
  u16* PD = (u16*)(p.ws + OFF_BIG);
  const int ntask = (nrows >> 4) * 2;
  for (int task = cx.bid * 8 + w; task < ntask; task += cx.nb * 8) {
    const int r0 = (task >> 1) * 16, k = task & 1;
    int base, t0, L;
    if (r0 < ML) { base = r0 & ~8191; t0 = r0 & 8191; L = SEQ; } else { base = ML + ((r0 - ML) & ~255); t0 = (r0 - ML) & 255; L = CTXL; }
    const int ch = (k * 64 + lane) * 8;
    const int hw = 1 << (ch >> 8);
    const u16* col = XN + (size_t)base * XNS + ch;
    u16* out = PD + (size_t)base * XNS + ch;
    float S[8];
#pragma unroll
    for (int j = 0; j < 8; j++) S[j] = 0.f;
    for (int s = max(t0 - hw, 0); s < min(t0 + hw, L); s++) {
      float v[8];
      unpack8(*(const uint4*)(col + (size_t)s * XNS), v);
#pragma unroll
      for (int j = 0; j < 8; j++) S[j] += v[j];
    }
#pragma unroll 4
    for (int i = 0; i < 16; i++) {
      const int t = t0 + i, tin = t + hw, tout = t - hw;
      const uint4 rme = *(const uint4*)(col + (size_t)t * XNS);
      const uint4 rin = *(const uint4*)(col + (size_t)min(tin, L - 1) * XNS);
      const uint4 rout = *(const uint4*)(col + (size_t)max(tout, 0) * XNS);
      const float fin = (tin < L) ? 1.f : 0.f, fout = (tout >= 0) ? 1.f : 0.f;
      const float invc = 1.f / (float)(min(tin, L) - max(tout, 0));
      float me[8], vi[8], vo[8], o[8];
      unpack8(rme, me); unpack8(rin, vi); unpack8(rout, vo);
#pragma unroll
      for (int j = 0; j < 8; j++) { o[j] = S[j] * invc - me[j]; S[j] += fin * vi[j] - fout * vo[j]; }
      *(uint4*)(out + (size_t)t * XNS) = pack8(o);
    }
  }
}

DI void grid_barrier(unsigned* ctr, unsigned target) {
  __syncthreads();
  if (threadIdx.x == 0) {
    __builtin_amdgcn_fence(__ATOMIC_RELEASE, "agent");
    asm volatile("s_waitcnt vmcnt(0)" ::: "memory");
    __hip_atomic_fetch_add(ctr, 1u, __ATOMIC_RELAXED, __HIP_MEMORY_SCOPE_AGENT);
    while (__hip_atomic_load(ctr, __ATOMIC_RELAXED, __HIP_MEMORY_SCOPE_AGENT) < target) __builtin_amdgcn_s_sleep(1);
    __builtin_amdgcn_fence(__ATOMIC_ACQUIRE, "agent");
    asm volatile("s_waitcnt vmcnt(0)" ::: "memory");
  }
  __syncthreads();
}

__global__ void __launch_bounds__(NTHR) fwd_megakernel(Params p) {
  extern __shared__ __attribute__((aligned(16))) char smem[];
  cg::grid_group grid = cg::this_grid();
  const float* MOD = (const float*)(p.ws + OFF_MOD);
  float* XC = (float*)(p.ws + OFF_XC);
  u16* XN = (u16*)(p.ws + OFF_XN);
  u16* BIG = (u16*)(p.ws + OFF_BIG);

  {
    Ctx cx; cx.tid = threadIdx.x; cx.bid = blockIdx.x; cx.nb = gridDim.x;
    phase_prep(cx, p, smem);
  }
  grid.sync();

  unsigned* bar = (unsigned*)(p.ws + OFF_BAR);
  unsigned nbar = 0;
#pragma unroll 1
  for (int ps = 0; ps < 4 * 15; ps++) {
    Ctx cx; cx.tid = threadIdx.x; cx.bid = blockIdx.x; cx.nb = gridDim.x;
    asm volatile("" : "+v"(cx.tid), "+s"(cx.bid), "+s"(cx.nb));
    const int layer = ps / 15, step = ps % 15;
    const bool even = (layer & 1) == 0;
    const int nMt = (layer < 3) ? 264 : 256;
    const int nrows = nMt * 256;
    const int ai = layer >> 1;
    const float* xsl = (layer == 0 && step < 3) ? p.x : p.out;
    const float* xsc = (layer == 0 && step < 3) ? p.ctx : XC;
    const float* modl = MOD + (size_t)layer * 9 * 9216;
    if (!even && step >= 6 && step <= 11) continue;
    GemmArgs g{};
    int gk = -1;
    g.nMt = nMt; g.xsl = xsl; g.xsc = xsc; g.xdl = p.out; g.xdc = XC; g.mod = modl; g.coef = 1.f; g.colscale = nullptr;
    switch (step) {
      case 0: convert_ffn_weights(cx, p, layer, smem); phase_norm(cx, p, xsl, xsc, nrows, layer, 0); break;
      case 1: case 13:
        gk = EPI_GU; g.A = XN; g.lda = XNS; g.W = (const u16*)(p.ws + OFF_WGU) + (step == 13 ? (size_t)5632 * XNS : 0); g.ldw = XNS;
        g.K = 1024; g.nNt = 22; g.outb = BIG; g.ldo = HS; g.ncols = 5632; break;
      case 2: case 14:
        gk = EPI_RES; g.A = BIG; g.lda = HS; g.W = (const u16*)(p.ws + OFF_WD) + (step == 14 ? (size_t)1024 * HS : 0); g.ldw = HS;
        g.K = DFF; g.nNt = 4; g.gidx = (step == 14) ? 8 : 2; g.coef = 0.5f; break;
      case 3: phase_norm(cx, p, xsl, xsc, nrows, layer, 1); break;
      case 4:
        if (even) {
          gk = EPI_RAW; g.A = XN; g.lda = XNS; g.W = (const u16*)(p.ws + OFF_WIN) + (size_t)ai * INWP * XNS; g.ldw = XNS;
          g.K = 1024; g.nNt = 9; g.outb = BIG; g.ldo = INW; g.ncols = INW;
        } else {
          phase_pooldiff(cx, p, nrows);
        }
        break;
      case 5:
        if (even) {
          phase_post1(cx, p, ai);
        } else {
          gk = EPI_RES; g.A = BIG; g.lda = XNS; g.a_koff = 256; g.W = (const u16*)(p.ws + OFF_WPOOL) + (size_t)ai * 1024 * 256; g.ldw = 256;
          g.K = 256; g.nNt = 4; g.gidx = 5; g.colscale = p.pool_scale + (size_t)ai * 1024;
        }
        break;
      case 6:
        gk = EPI_RAW; g.A = XN; g.lda = 384; g.W = (const u16*)(p.ws + OFF_WQB) + (size_t)ai * 768 * 384; g.ldw = 384;
        g.K = 384; g.nNt = 3; g.outb = BIG; g.ldo = 768; g.ncols = 768; break;
      case 7:
        gk = EPI_RAW; g.A = XN + (size_t)MT * 384; g.lda = 256; g.W = (const u16*)(p.ws + OFF_WKVB) + (size_t)ai * 1024 * 256; g.ldw = 256;
        g.K = 256; g.nNt = 4; g.outb = BIG + (size_t)MT * 768; g.ldo = 1024; g.ncols = 1024; break;
      case 8: phase_post2(cx, p, ai); break;
      case 9: phase_attn(cx, p, smem); break;
      case 10: phase_merge(cx, p, ai, layer == 0 ? 0.2f : 0.47071301831856f); break;
      case 11:
        gk = EPI_RES; g.A = XN; g.lda = XNS; g.W = (const u16*)(p.ws + OFF_WOUT) + (size_t)ai * 1024 * XNS; g.ldw = XNS;
        g.K = 1024; g.nNt = 4; g.gidx = 5; break;
      case 12: phase_norm(cx, p, xsl, xsc, nrows, layer, 2); break;
    }
    if (gk >= 0) gemm_phase(cx, g, gk, smem);
    if (ps != 4 * 15 - 1) { nbar++; grid_barrier(bar, nbar * gridDim.x); }
  }
}

extern "C" void kernel_launch(void* const* d_in, const int* in_sizes, int n_in, void* d_out, int out_size, void* d_ws,
                              size_t ws_size, hipStream_t stream) {
  static int grid_blocks = 0;
  if (grid_blocks == 0) {
    if (n_in != 23 || ws_size < WS_NEED) {
      fprintf(stderr, "kernel_launch: need 23 inputs and %zu bytes of workspace, got %d / %zu\n", (size_t)WS_NEED, n_in, ws_size);
      grid_blocks = -1;
      return;
    }
    int dev = 0, cus = 0, per_cu = 0;
    hipGetDevice(&dev);
    hipDeviceGetAttribute(&cus, hipDeviceAttributeMultiprocessorCount, dev);
    if (hipFuncSetAttribute((const void*)fwd_megakernel, hipFuncAttributeMaxDynamicSharedMemorySize, LDS_BYTES) != hipSuccess) {
      fprintf(stderr, "kernel_launch: hipFuncSetAttribute failed\n");
      grid_blocks = -1;
      return;
    }
    hipOccupancyMaxActiveBlocksPerMultiprocessor(&per_cu, (const void*)fwd_megakernel, NTHR, LDS_BYTES);
    if (per_cu < 1) per_cu = 1;
    (void)hipGetLastError();
    grid_blocks = cus * 1;
  }
  if (grid_blocks < 0) return;
  (void)hipMemsetAsync((char*)d_ws + OFF_BAR, 0, 256, stream);
  Params p{};
  const float** pp = (const float**)&p;
  for (int i = 0; i < 23; i++) pp[i] = (const float*)d_in[i];
  p.out = (float*)d_out;
  p.ws = (char*)d_ws;
  void* args[] = {&p};
  hipError_t e = hipLaunchCooperativeKernel((const void*)fwd_megakernel, dim3(grid_blocks), dim3(NTHR), args, LDS_BYTES, stream);
  if (e != hipSuccess) fprintf(stderr, "cooperative launch failed: %s (grid %d)\n", hipGetErrorString(e), grid_blocks);
}
```
